# Optimizing an MI355X kernel written in HIP

```python
import math
import jax, jax.numpy as jnp
from jax import lax
import numpy as np

D_MODEL = 1024
BATCH = 4
SEQ = 8192
DEPTH = 2

N_MIXERS = 2
N_HEADS = 16
HEAD_DIM = 64
N_KV_HEADS = 4
GROUP = N_HEADS // N_KV_HEADS
IDX_HEADS = 8
IDX_DIM = 64
TOPK_MAX = 256
Q_BLOCK = 128
ROPE_THETA = 10000.0
CONV_WIDTH = 3
FFN_HIDDEN = int(math.ceil(8 * D_MODEL / 3 / 256) * 256)
NORM_EPS = 1e-6
N_A = (DEPTH + 1) // 2
N_B = DEPTH // 2

Q_COLS = N_HEADS * HEAD_DIM
K_COLS = N_KV_HEADS * HEAD_DIM
V_COLS = N_KV_HEADS * HEAD_DIM
QI_COLS = IDX_HEADS * IDX_DIM
KI_COLS = IDX_DIM
WI_COLS = IDX_HEADS
ATTN_IN_COLS = Q_COLS + K_COLS + V_COLS + QI_COLS + KI_COLS + WI_COLS

kernel_name = "hybrid_dsa_shortconv_adaln_block"


def _rmsnorm(x, g):
    xf = x.astype(jnp.float32)
    y = xf * lax.rsqrt(jnp.mean(xf * xf, axis=-1, keepdims=True) + NORM_EPS)
    return (y * g.astype(jnp.float32)).astype(x.dtype)


def _layernorm(x, g, b):
    xf = x.astype(jnp.float32)
    mu = jnp.mean(xf, axis=-1, keepdims=True)
    var = jnp.mean(jnp.square(xf - mu), axis=-1, keepdims=True)
    y = (xf - mu) * lax.rsqrt(var + NORM_EPS)
    return (y * g.astype(jnp.float32) + b.astype(jnp.float32)).astype(x.dtype)


def _rope(x, pos):
    d = x.shape[-1]
    half = d // 2
    inv_freq = ROPE_THETA ** (-(jnp.arange(half, dtype=jnp.float32) * 2.0 / d))
    ang = pos.astype(jnp.float32)[..., None] * inv_freq
    cos = jnp.cos(ang)[:, :, None, :]
    sin = jnp.sin(ang)[:, :, None, :]
    xf = x.astype(jnp.float32)
    x1, x2 = xf[..., :half], xf[..., half:]
    out = jnp.concatenate([x1 * cos - x2 * sin, x2 * cos + x1 * sin], axis=-1)
    return out.astype(x.dtype)


def _dsa_mixer(h, positions, w_in, q_norm_g, k_norm_g, idx_k_ln_g, idx_k_ln_b, w_out):
    Bn, T, _ = h.shape
    proj = h @ w_in
    o0 = 0
    q = proj[..., o0:o0 + Q_COLS].reshape(Bn, T, N_HEADS, HEAD_DIM); o0 += Q_COLS
    k = proj[..., o0:o0 + K_COLS].reshape(Bn, T, N_KV_HEADS, HEAD_DIM); o0 += K_COLS
    v = proj[..., o0:o0 + V_COLS].reshape(Bn, T, N_KV_HEADS, HEAD_DIM); o0 += V_COLS
    qi = proj[..., o0:o0 + QI_COLS].reshape(Bn, T, IDX_HEADS, IDX_DIM); o0 += QI_COLS
    ki = proj[..., o0:o0 + KI_COLS]; o0 += KI_COLS
    wi = proj[..., o0:o0 + WI_COLS]

    q = _rope(_rmsnorm(q, q_norm_g), positions)
    k = _rope(_rmsnorm(k, k_norm_g), positions)
    qi = _rope(qi, positions)
    ki = _rope(_layernorm(ki, idx_k_ln_g, idx_k_ln_b)[:, :, None, :], positions)[:, :, 0, :]
    wi = wi * (IDX_HEADS ** -0.5 * IDX_DIM ** -0.5)

    topk = min(TOPK_MAX, T // 4)
    n_blk = T // Q_BLOCK
    key_idx = jnp.arange(T)
    scale = HEAD_DIM ** -0.5

    def to_blocks(a):
        return jnp.moveaxis(a.reshape(Bn, n_blk, Q_BLOCK, *a.shape[2:]), 1, 0)

    def block_fn(args):
        qb, qib, wib, start = args
        t_idx = start + jnp.arange(Q_BLOCK)
        s = jnp.einsum('bqhd,bsd->bqhs', qib, ki)
        score = jnp.einsum('bqhs,bqh->bqs', jax.nn.relu(s), wib).astype(jnp.float32)
        causal = key_idx[None, :] <= t_idx[:, None]
        score = jnp.where(causal[None], score, -jnp.inf)
        _, sel = lax.top_k(score, topk)
        sel_ok = sel <= t_idx[None, :, None]
        kg = jax.vmap(lambda a, i: a[i])(k, sel)
        vg = jax.vmap(lambda a, i: a[i])(v, sel)
        qg = qb.reshape(Bn, Q_BLOCK, N_KV_HEADS, GROUP, HEAD_DIM)
        logits = jnp.einsum('bqgrd,bqkgd->bqgrk', qg, kg).astype(jnp.float32) * scale
        logits = jnp.where(sel_ok[:, :, None, None, :], logits, -1e30)
        p = jax.nn.softmax(logits, axis=-1).astype(vg.dtype)
        o = jnp.einsum('bqgrk,bqkgd->bqgrd', p, vg)
        return o.reshape(Bn, Q_BLOCK, N_HEADS * HEAD_DIM)

    starts = jnp.arange(n_blk) * Q_BLOCK
    o = lax.map(block_fn, (to_blocks(q), to_blocks(qi), to_blocks(wi), starts))
    o = jnp.moveaxis(o, 0, 1).reshape(Bn, T, N_HEADS * HEAD_DIM)
    return o @ w_out


def _short_conv_mixer(h, w_in, conv_w, w_out):
    proj = h @ w_in
    b_gate, c_gate, u = jnp.split(proj, 3, axis=-1)
    z = c_gate * u
    z = lax.conv_general_dilated(
        z, conv_w[:, None, :].astype(z.dtype),
        window_strides=(1,), padding=[(CONV_WIDTH - 1, 0)],
        dimension_numbers=('NWC', 'WIO', 'NWC'),
        feature_group_count=z.shape[-1])
    return (b_gate * z) @ w_out


def _swiglu(h, w_gate, w_up, w_down):
    return (jax.nn.silu(h @ w_gate) * (h @ w_up)) @ w_down


def setup_inputs(seed: int = 0) -> dict:
    key = jax.random.key(seed)
    ks = jax.random.split(key, 20)
    D = D_MODEL

    def nrm(k, shape, s):
        return jax.random.normal(k, shape, dtype=jnp.float32) * s

    x = nrm(ks[0], (BATCH, SEQ, D), 1.0)
    c = nrm(ks[1], (BATCH, D), 1.0)
    positions = (jnp.arange(SEQ, dtype=jnp.int32)[None, :]
                 + jax.random.randint(ks[2], (BATCH, 1), 0, 1024, dtype=jnp.int32))
    ada_w = nrm(ks[3], (DEPTH, D, 6 * D), 0.5 * D ** -0.5)
    ada_b = nrm(ks[4], (DEPTH, 6 * D), 0.02)
    norm1_g = 1.0 + nrm(ks[5], (DEPTH, D), 0.02)
    norm2_g = 1.0 + nrm(ks[6], (DEPTH, D), 0.02)
    attn_w_in = nrm(ks[7], (N_A, D, ATTN_IN_COLS), D ** -0.5)
    attn_q_norm_g = 1.0 + nrm(ks[8], (N_A, HEAD_DIM), 0.02)
    attn_k_norm_g = 1.0 + nrm(ks[9], (N_A, HEAD_DIM), 0.02)
    idx_k_ln_g = 1.0 + nrm(ks[10], (N_A, IDX_DIM), 0.02)
    idx_k_ln_b = nrm(ks[11], (N_A, IDX_DIM), 0.02)
    attn_w_out = nrm(ks[12], (N_A, N_HEADS * HEAD_DIM, D), (N_HEADS * HEAD_DIM) ** -0.5)
    conv_w_in = nrm(ks[13], (N_B, D, 3 * D), D ** -0.5)
    conv_w = nrm(ks[14], (N_B, CONV_WIDTH, D), CONV_WIDTH ** -0.5)
    conv_w_out = nrm(ks[15], (N_B, D, D), D ** -0.5)
    ffn_w_gate = nrm(ks[16], (DEPTH, D, FFN_HIDDEN), D ** -0.5)
    ffn_w_up = nrm(ks[17], (DEPTH, D, FFN_HIDDEN), D ** -0.5)
    ffn_w_down = nrm(ks[18], (DEPTH, FFN_HIDDEN, D), FFN_HIDDEN ** -0.5)
    return {"x": x, "c": c, "positions": positions,
            "ada_w": ada_w, "ada_b": ada_b, "norm1_g": norm1_g, "norm2_g": norm2_g,
            "attn_w_in": attn_w_in, "attn_q_norm_g": attn_q_norm_g,
            "attn_k_norm_g": attn_k_norm_g, "idx_k_ln_g": idx_k_ln_g,
            "idx_k_ln_b": idx_k_ln_b, "attn_w_out": attn_w_out,
            "conv_w_in": conv_w_in, "conv_w": conv_w, "conv_w_out": conv_w_out,
            "ffn_w_gate": ffn_w_gate, "ffn_w_up": ffn_w_up, "ffn_w_down": ffn_w_down}


def reference(x, c, positions, ada_w, ada_b, norm1_g, norm2_g,
              attn_w_in, attn_q_norm_g, attn_k_norm_g, idx_k_ln_g, idx_k_ln_b, attn_w_out,
              conv_w_in, conv_w, conv_w_out, ffn_w_gate, ffn_w_up, ffn_w_down):
    c_act = jax.nn.silu(c)
    for i in range(DEPTH):
        mod = c_act @ ada_w[i] + ada_b[i]
        sh1, sc1, g1, sh2, sc2, g2 = [m[:, None, :] for m in jnp.split(mod, 6, axis=-1)]
        h = _rmsnorm(x, norm1_g[i]) * (1.0 + sc1) + sh1
        if i % N_MIXERS == 0:
            j = i // N_MIXERS
            y = _dsa_mixer(h, positions, attn_w_in[j], attn_q_norm_g[j], attn_k_norm_g[j],
                           idx_k_ln_g[j], idx_k_ln_b[j], attn_w_out[j])
        else:
            j = i // N_MIXERS
            y = _short_conv_mixer(h, conv_w_in[j], conv_w[j], conv_w_out[j])
        x = x + g1 * y
        h = _rmsnorm(x, norm2_g[i]) * (1.0 + sc2) + sh2
        x = x + g2 * _swiglu(h, ffn_w_gate[i], ffn_w_up[i], ffn_w_down[i])
    return x
```

```cpp
#include <hip/hip_runtime.h>
#include <hip/hip_cooperative_groups.h>
#include <cstdio>
#include <cstdint>
#include <cmath>
namespace cg = cooperative_groups;
namespace pg8 {
#define PG8_LAS __attribute__((address_space(3)))
typedef unsigned short bf16_t;
typedef short bf16x8 __attribute__((ext_vector_type(8)));
typedef float f32x4 __attribute__((ext_vector_type(4)));
typedef unsigned u32x4 __attribute__((ext_vector_type(4)));
constexpr int BM = 256, BK = 64, HALF = 128, HTB = HALF * BK * 2  , STAGE_BYTES = 8 * HTB, NXCD = 8, WGM = 8;

__host__ __device__ __forceinline__ int lds_byte(int r, int c) { const int st = (r >> 4) * 2 + (c >> 5), rr = r & 15, cc = c & 31, ob = rr * 64 + cc * 2; return st * 1024 + (ob ^ (((ob >> 9) & 1) << 5)); }
__host__ __device__ __forceinline__ void stage_rc(int b, int& R, int& C) { const int st = b / 1024, sb = b % 1024, swz = sb ^ (((sb >> 9) & 1) << 5); R = (st >> 1) * 16 + swz / 64; C = (st & 1) * 32 + (swz % 64) / 2; }
__host__ __device__ __forceinline__ int perm32(int rho) { const int n = rho >> 4, i = rho & 15; return 8 * (i >> 2) + 4 * n + (i & 3); }

struct Unit { int pm, pn; };
struct Gemm { const bf16_t* A; const bf16_t* Bt; int M, N, K; };

struct StaticOrder {
    int nM, nN, nwg, G, c;
    __host__ __device__ void init(int M, int N, int G_, int c_) { nM = M / BM; nN = N / BM; nwg = nM * nN; G = G_; c = c_; }
    __host__ __device__ bool next(int i, Unit& u) const {
        const long L = (long)i * G + c; if (L >= nwg) return false;
        int wgid = (int)L; { const int q = nwg / NXCD, r = nwg % NXCD, xcd = wgid % NXCD, off = wgid / NXCD; wgid = (xcd < r ? xcd * (q + 1) : r * (q + 1) + (xcd - r) * q) + off; }
        const int nig = WGM * nN, gid = wgid / nig, fm = gid * WGM, gsz = (nM - fm) < WGM ? (nM - fm) : WGM;
        u.pm = fm + ((wgid % nig) % gsz); u.pn = (wgid % nig) / gsz; return true;
    }
    __device__ __forceinline__ void a_ready(const Unit&) const {}
    __device__ __forceinline__ void done(const Unit&) const {}
};

__device__ __forceinline__ unsigned cvt_pk_bf16(float lo, float hi) { unsigned r; asm volatile("v_cvt_pk_bf16_f32 %0, %1, %2" : "=v"(r) : "v"(lo), "v"(hi)); return r; }

template <class Epi, class Sched, bool ALIGN_EPI = false, bool SP2 = false>
__device__ __forceinline__ void gemm_phase(PG8_LAS unsigned char* lds, const Gemm g, const Sched& S, const Epi& E) {
    const int tid = threadIdx.x, wid = __builtin_amdgcn_readfirstlane(tid >> 6), lane = tid & 63, wr = wid >> 2, wc = wid & 3, fr = lane & 15, fq = lane >> 4;
    const int K = g.K, nt = K / BK;
    unsigned voffA[2], voffB[2];
#pragma unroll
    for (int i = 0; i < 2; ++i) { int R, C; stage_rc(tid * 16 + i * 8192, R, C); const int Rb = Epi::PERM ? ((R & ~31) + perm32(R & 31)) : R;
        voffA[i] = (unsigned)(R * K + C) * 2u; voffB[i] = (unsigned)(Rb * K + C) * 2u; }
    const size_t kstep = (size_t)(BK * 2);
    const size_t hstep = (size_t)HALF * K * 2;
    const size_t tstep = 2 * hstep;
    const unsigned ldsw = (unsigned)wid * 1024u;
    const int aoff = lds_byte(wr * 64 + fr, fq * 8), boff = lds_byte(wc * 32 + fr, fq * 8);
#define PG8_SA(b, h) (((b) * 2 + (h)) * HTB)
#define PG8_SB(b, h) ((4 + (b) * 2 + (h)) * HTB)
#define PG8_STAGE(bufoff, gbase, voff) do { _Pragma("unroll") for (int _i = 0; _i < 2; ++_i) \
        __builtin_amdgcn_global_load_lds((const unsigned*)((const char*)(gbase) + (voff)[_i]), (PG8_LAS unsigned*)(lds + (bufoff) + ldsw + _i * 8192), 16, 0, 0); } while (0)
#define PG8_LDA(dst, b, h) do { _Pragma("unroll") for (int m = 0; m < 4; ++m) _Pragma("unroll") for (int k = 0; k < 2; ++k) dst[m][k] = *(const PG8_LAS bf16x8*)(lds + PG8_SA(b, h) + aoff + m * 2048 + k * 1024); } while (0)
#define PG8_LDB(dst, b, h) do { _Pragma("unroll") for (int n = 0; n < 2; ++n) _Pragma("unroll") for (int k = 0; k < 2; ++k) dst[n][k] = *(const PG8_LAS bf16x8*)(lds + PG8_SB(b, h) + boff + n * 2048 + k * 1024); } while (0)
#define PG8_MMA(ai, bj, At, Bt) do { __builtin_amdgcn_s_setprio(1); _Pragma("unroll") for (int m = 0; m < 4; ++m) _Pragma("unroll") for (int n = 0; n < 2; ++n) _Pragma("unroll") for (int k = 0; k < 2; ++k) \
        acc[ai][bj][m][n] = __builtin_amdgcn_mfma_f32_16x16x32_bf16(Bt[n][k], At[m][k], acc[ai][bj][m][n], 0, 0, 0); __builtin_amdgcn_s_setprio(0); } while (0)
#define PG8_WAIT_V(n) asm volatile("s_waitcnt vmcnt(" #n ")" ::: "memory")
#define PG8_WAIT_L(n) asm volatile("s_waitcnt lgkmcnt(" #n ")" ::: "memory")
#define PG8_BAR __builtin_amdgcn_s_barrier()
#define PG8_SCHED __builtin_amdgcn_sched_barrier(0)
    Unit cur, nxt; int ui = 0;
    if (!S.next(0, cur)) return;
    f32x4 acc[2][2][4][2];
#pragma unroll
    for (int a = 0; a < 2; ++a)
#pragma unroll
        for (int b = 0; b < 2; ++b)
#pragma unroll
            for (int m = 0; m < 4; ++m)
#pragma unroll
                for (int n = 0; n < 2; ++n) acc[a][b][m][n] = (f32x4){0.f, 0.f, 0.f, 0.f};
    bf16x8 At[4][2], B0[2][2], B1[2][2];
    const char* cA = (const char*)g.A + (size_t)cur.pm * tstep; const char* cB = (const char*)g.Bt + (size_t)cur.pn * tstep;
    S.a_ready(cur);
    if constexpr (SP2) {
        PG8_STAGE(PG8_SB(0, 0), cB, voffB); PG8_STAGE(PG8_SB(0, 1), cB + hstep, voffB); PG8_STAGE(PG8_SA(0, 0), cA, voffA); PG8_STAGE(PG8_SA(0, 1), cA + hstep, voffA);
        if (wr == 1) PG8_BAR;
        PG8_WAIT_V(2); PG8_BAR;
        PG8_STAGE(PG8_SB(1, 0), cB + kstep, voffB); PG8_STAGE(PG8_SA(1, 0), cA + kstep, voffA); PG8_STAGE(PG8_SB(1, 1), cB + hstep + kstep, voffB);
        PG8_WAIT_V(6); PG8_BAR;
    } else {
        PG8_STAGE(PG8_SB(0, 0), cB, voffB); PG8_STAGE(PG8_SA(0, 0), cA, voffA); PG8_STAGE(PG8_SB(0, 1), cB + hstep, voffB); PG8_STAGE(PG8_SA(0, 1), cA + hstep, voffA);
        if (wr == 1) PG8_BAR;
        PG8_WAIT_V(4); PG8_BAR;
        PG8_STAGE(PG8_SB(1, 0), cB + kstep, voffB); PG8_STAGE(PG8_SA(1, 0), cA + kstep, voffA); PG8_STAGE(PG8_SB(1, 1), cB + hstep + kstep, voffB);
        PG8_WAIT_V(6); PG8_BAR;
    }
    for (;;) {
        const bool has_next = S.next(ui + 1, nxt);
        const char* nA = has_next ? (const char*)g.A + (size_t)nxt.pm * tstep : cA; const char* nB = has_next ? (const char*)g.Bt + (size_t)nxt.pn * tstep : cB;
        for (int t = 0; t < nt; t += 2) {
            const bool last = (t == nt - 2);
            const char* a1 = cA + (size_t)(t + 1) * kstep;
            const char* a2 = last ? nA : cA + (size_t)(t + 2) * kstep; const char* b2 = last ? nB : cB + (size_t)(t + 2) * kstep;
            const char* a3 = a2 + kstep; const char* b3 = b2 + kstep;
            if (last && has_next) S.a_ready(nxt);
            if constexpr (SP2) {
            PG8_LDB(B0, 0, 0); PG8_LDB(B1, 0, 1); PG8_SCHED; PG8_LDA(At, 0, 0); PG8_STAGE(PG8_SA(1, 1), a1 + hstep, voffA);
            PG8_WAIT_V(8); PG8_WAIT_L(0); PG8_BAR; PG8_MMA(0, 0, At, B0); PG8_MMA(0, 1, At, B1); PG8_BAR; PG8_SCHED;
            PG8_LDA(At, 0, 1); PG8_STAGE(PG8_SB(0, 0), b2, voffB); PG8_STAGE(PG8_SB(0, 1), b2 + hstep, voffB); PG8_STAGE(PG8_SA(0, 0), a2, voffA);
            PG8_WAIT_V(8); PG8_WAIT_L(0); PG8_BAR; PG8_MMA(1, 0, At, B0); PG8_MMA(1, 1, At, B1); PG8_BAR; PG8_SCHED;
            PG8_LDB(B0, 1, 0); PG8_LDB(B1, 1, 1); PG8_SCHED; PG8_LDA(At, 1, 0); PG8_STAGE(PG8_SA(0, 1), a2 + hstep, voffA);
            PG8_WAIT_V(8); PG8_WAIT_L(0); PG8_BAR; PG8_MMA(0, 0, At, B0); PG8_MMA(0, 1, At, B1); PG8_BAR; PG8_SCHED;
            PG8_LDA(At, 1, 1); PG8_STAGE(PG8_SB(1, 0), b3, voffB); PG8_STAGE(PG8_SB(1, 1), b3 + hstep, voffB); PG8_STAGE(PG8_SA(1, 0), a3, voffA);
            PG8_WAIT_V(8); PG8_WAIT_L(0); PG8_BAR; PG8_MMA(1, 0, At, B0); PG8_MMA(1, 1, At, B1); PG8_BAR; PG8_SCHED;
            } else {
            PG8_LDB(B0, 0, 0); PG8_SCHED; PG8_LDA(At, 0, 0); PG8_STAGE(PG8_SA(1, 1), a1 + hstep, voffA);
            PG8_WAIT_L(8); PG8_BAR; PG8_WAIT_L(0); PG8_MMA(0, 0, At, B0); PG8_BAR; PG8_SCHED;
            PG8_LDB(B1, 0, 1); PG8_STAGE(PG8_SB(0, 0), b2, voffB);
            PG8_BAR; PG8_WAIT_L(0); PG8_MMA(0, 1, At, B1); PG8_BAR;
            PG8_LDA(At, 0, 1); PG8_STAGE(PG8_SA(0, 0), a2, voffA);
            PG8_BAR; PG8_WAIT_L(0); PG8_MMA(1, 0, At, B0); PG8_BAR; PG8_SCHED;
            PG8_STAGE(PG8_SB(0, 1), b2 + hstep, voffB);
            PG8_WAIT_V(6); PG8_BAR; PG8_MMA(1, 1, At, B1); PG8_BAR;
            PG8_LDB(B0, 1, 0); PG8_SCHED; PG8_LDA(At, 1, 0); PG8_STAGE(PG8_SA(0, 1), a2 + hstep, voffA);
            PG8_WAIT_L(8); PG8_BAR; PG8_WAIT_L(0); PG8_MMA(0, 0, At, B0); PG8_BAR; PG8_SCHED;
            PG8_LDB(B1, 1, 1); PG8_STAGE(PG8_SB(1, 0), b3, voffB);
            PG8_BAR; PG8_WAIT_L(0); PG8_MMA(0, 1, At, B1); PG8_BAR;
            PG8_LDA(At, 1, 1); PG8_STAGE(PG8_SA(1, 0), a3, voffA);
            PG8_BAR; PG8_WAIT_L(0); PG8_MMA(1, 0, At, B0); PG8_BAR; PG8_SCHED;
            PG8_STAGE(PG8_SB(1, 1), b3 + hstep, voffB);
            PG8_WAIT_V(6); PG8_BAR; PG8_MMA(1, 1, At, B1); PG8_BAR;
            }
        }
        if constexpr (ALIGN_EPI) { if (wr == 0) PG8_BAR; }
        if constexpr (!Epi::AFTER_DRAIN) { E(acc, cur, wr, wc, fr, fq); S.done(cur); }
        if (!has_next) break;
#pragma unroll
        for (int a = 0; a < 2; ++a)
#pragma unroll
            for (int b = 0; b < 2; ++b)
#pragma unroll
                for (int m = 0; m < 4; ++m)
#pragma unroll
                    for (int n = 0; n < 2; ++n) acc[a][b][m][n] = (f32x4){0.f, 0.f, 0.f, 0.f};
        cur = nxt; cA = nA; cB = nB; ++ui;
        if constexpr (ALIGN_EPI) { if (wr == 1) PG8_BAR; }
    }
    PG8_WAIT_V(0);
    if constexpr (!ALIGN_EPI) { if (wr == 0) PG8_BAR; }
    PG8_BAR;
    if constexpr (Epi::AFTER_DRAIN) { E.fused(acc, cur, wr, wc, fr, fq, lds, wid, lane); S.done(cur); }
#undef PG8_SA
#undef PG8_SB
#undef PG8_STAGE
#undef PG8_LDA
#undef PG8_LDB
#undef PG8_MMA
#undef PG8_WAIT_V
#undef PG8_WAIT_L
#undef PG8_BAR
#undef PG8_SCHED
}
}

constexpr int NBATCH = 4, T = 8192, D = 1024, M = NBATCH * T;
constexpr int FF = 2816, NGU = 2 * FF;
constexpr int NATT = 2120, NATTP = 2304, NCI = 3072;
constexpr float EPS = 1e-6f;
constexpr int NWAVES = 8, NTHR = 512;
constexpr int LDS_BYTES = 155648, LDS_BARST = 155136;

#define GAS __attribute__((address_space(1)))
#define LAS __attribute__((address_space(3)))
typedef unsigned short bf16;
typedef unsigned v4u __attribute__((ext_vector_type(4)));
typedef unsigned v2u __attribute__((ext_vector_type(2)));
typedef float f32x4 __attribute__((ext_vector_type(4)));
typedef float f32x16 __attribute__((ext_vector_type(16)));
typedef short bf16x8 __attribute__((ext_vector_type(8)));
#define LDS_WAIT() asm volatile("s_waitcnt lgkmcnt(0)" ::: "memory")

constexpr size_t MiB = 1u << 20;
constexpr size_t WS_WATT = 0, WS_WAO = 5 * MiB, WS_WGU0 = 7 * MiB, WS_WGU1 = 18 * MiB, WS_WD0 = 29 * MiB, WS_WD1 = 35 * MiB,
                 WS_WCI = 41 * MiB, WS_WCO = 47 * MiB, WS_MOD = 49 * MiB, WS_INVF = 50 * MiB, WS_H = 64 * MiB, WS_R1 = 128 * MiB,
                 WS_Q = 320 * MiB, WS_QI = 384 * MiB, WS_K = 416 * MiB, WS_V = 432 * MiB,
                 WS_KI = 272 * MiB, WS_WI = 276 * MiB, WS_SEL = 277 * MiB  , WS_BAR = 60 * MiB, WS_XR = 448 * MiB  , WS_END = 512 * MiB;

#define XB_TMO      128
#define XB_XCNT(j)  (256  + 64 * (j))
#define XB_XSUB(j)  (1280 + 64 * (j))
#define XB_XGEN(j)  (2304 + 64 * (j))
#define XB_TOP      3328
#define XB_TOPGEN   3392
#define XCD_BAR_WORDS 3456
#define XB_SPIN_CAP (1u << 18)

__device__ __forceinline__ unsigned xb_ld(unsigned* p)              { return __hip_atomic_load(p, __ATOMIC_RELAXED, __HIP_MEMORY_SCOPE_AGENT); }
__device__ __forceinline__ unsigned xb_add(unsigned* p, unsigned v) { return __hip_atomic_fetch_add(p, v, __ATOMIC_RELAXED, __HIP_MEMORY_SCOPE_AGENT); }
__device__ __forceinline__ unsigned xb_xcc_id() { return (unsigned)__builtin_amdgcn_s_getreg((3 << 11) | 20) & 0xFu; }
#define XB_SPIN(cond, bar) do { unsigned _sp = 0; while (cond) { __builtin_amdgcn_s_sleep(1); \
    if ((++_sp & 255u) == 0u) { if (xb_ld(&(bar)[XB_TMO])) break; if (_sp > XB_SPIN_CAP) { atomicAdd(&(bar)[XB_TMO], 1u); break; } } } } while (0)

struct XcdBarrier {
    unsigned* bar; unsigned x;
    volatile LAS unsigned* st;
};

__device__ __forceinline__ XcdBarrier xcd_barrier_post(unsigned* bar, volatile LAS unsigned* st) {
    XcdBarrier b; b.bar = bar; b.x = xb_xcc_id(); b.st = st;
    if (threadIdx.x == 0) (void)xb_add(&bar[XB_XCNT(b.x)], 1u);
    return b;
}
__device__ __forceinline__ void xcd_barrier_complete(unsigned* bar, unsigned x, unsigned& nloc, unsigned& nx) {
    const unsigned G = gridDim.x * gridDim.y * gridDim.z;
    unsigned sum, cnt, mine, sp = 0u;
    for (;;) {
        sum = 0u; cnt = 0u; mine = 0u;
#pragma unroll
        for (unsigned j = 0; j < 16; ++j) { const unsigned c = xb_ld(&bar[XB_XCNT(j)]); sum += c; cnt += (c > 0u) ? 1u : 0u; mine = (j == x) ? c : mine; }
        if (sum == G) break;
        __builtin_amdgcn_s_sleep(1);
        if ((++sp & 255u) == 0u) { if (xb_ld(&bar[XB_TMO])) break; if (sp > XB_SPIN_CAP) { atomicAdd(&bar[XB_TMO], 1u); break; } }
    }
    nloc = mine > 0u ? mine : 1u; nx = cnt > 0u ? cnt : 1u;
}

__device__ __forceinline__ void xcd_barrier(const XcdBarrier& b) {
    asm volatile("s_waitcnt vmcnt(0)" ::: "memory");
    __syncthreads();
    if (threadIdx.x == 0) {
        unsigned* bar = b.bar;
        __builtin_amdgcn_s_waitcnt(0);
        unsigned nloc = b.st[0], nx = b.st[1];
        if (nloc == 0u) { xcd_barrier_complete(bar, b.x, nloc, nx); b.st[0] = nloc; b.st[1] = nx; }
        const unsigned old = xb_add(&bar[XB_XSUB(b.x)], 1u);
        const unsigned gen = old / nloc;
        if (old + 1u == (gen + 1u) * nloc) {
            __builtin_amdgcn_fence(__ATOMIC_RELEASE, "agent");
            asm volatile("s_waitcnt vmcnt(0)" ::: "memory");
            const unsigned og = xb_add(&bar[XB_TOP], 1u);
            const unsigned tg = og / nx;
            if (og + 1u == (tg + 1u) * nx) xb_add(&bar[XB_TOPGEN], 1u);
            else XB_SPIN(xb_ld(&bar[XB_TOPGEN]) == tg, bar);
            __builtin_amdgcn_fence(__ATOMIC_ACQUIRE, "agent");
            xb_add(&bar[XB_XGEN(b.x)], 1u);
            asm volatile("s_waitcnt vmcnt(0)" ::: "memory");
        } else {
            XB_SPIN(xb_ld(&bar[XB_XGEN(b.x)]) == gen, bar);
            __builtin_amdgcn_fence(__ATOMIC_ACQUIRE, "agent");
            asm volatile("s_waitcnt vmcnt(0)" ::: "memory");
        }
    }
    __syncthreads();
}


struct Params {
    const float* x; const float* c; const int* pos;
    const float* ada_w; const float* ada_b; const float* n1g; const float* n2g;
    const float* attn_w_in; const float* qg; const float* kg; const float* lng; const float* lnb; const float* attn_w_out;
    const float* conv_w_in; const float* conv_w; const float* conv_w_out;
    const float* wg; const float* wu; const float* wd;
    float* out; unsigned char* ws;
    float inv_freq[32];
};

__device__ __forceinline__ float bf2f(unsigned v) { return __builtin_bit_cast(float, v << 16); }
__device__ __forceinline__ unsigned f2bf(float f) { unsigned u = __builtin_bit_cast(unsigned, f); return (u + 0x7fffu + ((u >> 16) & 1u)) >> 16; }
__device__ __forceinline__ unsigned pk2(float lo, float hi) { return pg8::cvt_pk_bf16(lo, hi); }
__device__ __forceinline__ float wave_sum(float v) {
#pragma unroll
    for (int o = 1; o < 64; o <<= 1) v += __shfl_xor(v, o);
    return v;
}

__device__ __forceinline__ void sincos_ang(float ang, float& s, float& c);
struct EpiAttnIn {
    static constexpr bool PERM = true, AFTER_DRAIN = false;
    bf16* O; int ldc; unsigned char* ws;
    __device__ __forceinline__ void operator()(const pg8::f32x4 (&acc)[2][2][4][2], const pg8::Unit& u, int wr, int wc, int fr, int fq) const {
        const int row0 = u.pm * 256 + wr * 64 + fr;
        bf16* Kb = (bf16*)(ws + WS_K); bf16* Vb = (bf16*)(ws + WS_V); bf16* KIb = (bf16*)(ws + WS_KI); float* WIb = (float*)(ws + WS_WI);
        const float* invf = (const float*)(ws + WS_INVF);
        if (u.pn == 5) {
#pragma unroll
            for (int ai = 0; ai < 2; ++ai)
#pragma unroll
                for (int m = 0; m < 4; ++m) { bf16* rowp = Vb + (size_t)(row0 + ai * 128 + m * 16) * 256 + wc * 64 + 8 * fq;
#pragma unroll
                    for (int bj = 0; bj < 2; ++bj) { const pg8::f32x4 v0 = acc[ai][bj][m][0], v1 = acc[ai][bj][m][1];
                        v4u w; w.x = pk2(v0[0], v0[1]); w.y = pk2(v0[2], v0[3]); w.z = pk2(v1[0], v1[1]); w.w = pk2(v1[2], v1[3]);
                        *(v4u*)(rowp + bj * 32) = w; } }
            return;
        }
        if (u.pn == 8 && wc >= 2) return;
        if (u.pn == 8 && wc == 1) {
            if (fq == 0) {
#pragma unroll
                for (int ai = 0; ai < 2; ++ai)
#pragma unroll
                    for (int m = 0; m < 4; ++m) { float* wp = WIb + (size_t)(row0 + ai * 128 + m * 16) * 8;
                        *(f32x4*)wp = acc[ai][0][m][0] * 0.04419417382415922f; *(f32x4*)(wp + 4) = acc[ai][0][m][1] * 0.04419417382415922f; }
            }
            return;
        }
        if (u.pn == 6 || u.pn == 7) {
            float fq8[8];
#pragma unroll
            for (int e = 0; e < 8; ++e) fq8[e] = invf[8 * fq + e];
            const int* posq = (const int*)((const unsigned long long*)(ws + WS_INVF + 256))[0];
#pragma unroll
            for (int ai = 0; ai < 2; ++ai)
#pragma unroll
                for (int m = 0; m < 4; ++m) { const int row = row0 + ai * 128 + m * 16; const float posf = (float)posq[row]; float ol[8], oh[8];
#pragma unroll
                    for (int e = 0; e < 8; ++e) { const float xl = bf2f(f2bf(acc[ai][0][m][e >> 2][e & 3])), xh = bf2f(f2bf(acc[ai][1][m][e >> 2][e & 3])); float sn, cs; sincos_ang(posf * fq8[e], sn, cs);
                        ol[e] = xl * cs - xh * sn; oh[e] = xh * cs + xl * sn; }
                    v4u wl, wh; wl.x = pk2(ol[0], ol[1]); wl.y = pk2(ol[2], ol[3]); wl.z = pk2(ol[4], ol[5]); wl.w = pk2(ol[6], ol[7]);
                    wh.x = pk2(oh[0], oh[1]); wh.y = pk2(oh[2], oh[3]); wh.z = pk2(oh[4], oh[5]); wh.w = pk2(oh[6], oh[7]);
                    bf16* qp = O + (size_t)row * ldc + u.pn * 256 + wc * 64 + 8 * fq; *(v4u*)qp = wl; *(v4u*)(qp + 32) = wh; }
            return;
        }
        const bool isk = (u.pn <= 4), isq = (u.pn < 4);
        const unsigned long long* ptab = (const unsigned long long*)(ws + WS_INVF + 256);
        const int* pos = (const int*)ptab[0]; const float* kg = (const float*)ptab[1]; const float* lng = (const float*)ptab[2]; const float* lnb = (const float*)ptab[3]; const float* qg = (const float*)ptab[4];
        float fr8[8];
#pragma unroll
        for (int e = 0; e < 8; ++e) fr8[e] = invf[8 * fq + e];
#pragma unroll
        for (int ai = 0; ai < 2; ++ai)
#pragma unroll
            for (int m = 0; m < 4; ++m) { const int row = row0 + ai * 128 + m * 16;
                float vl[8], vh[8];
#pragma unroll
                for (int e = 0; e < 8; ++e) { vl[e] = acc[ai][0][m][e >> 2][e & 3]; vh[e] = acc[ai][1][m][e >> 2][e & 3]; }
                float mu = 0.f;
                if (!isk) { float sm = 0.f;
#pragma unroll
                    for (int e = 0; e < 8; ++e) sm += vl[e] + vh[e];
                    sm += __shfl_xor(sm, 16); sm += __shfl_xor(sm, 32); mu = sm * (1.f / 64.f); }
                float ss = 0.f;
#pragma unroll
                for (int e = 0; e < 8; ++e) { vl[e] -= mu; vh[e] -= mu; ss += vl[e] * vl[e] + vh[e] * vh[e]; }
                ss += __shfl_xor(ss, 16); ss += __shfl_xor(ss, 32);
                const float rs = rsqrtf(ss * (1.f / 64.f) + EPS) * (isq ? 0.125f : 1.f), posf = (float)pos[row];
                float ol[8], oh[8];
                const float* lbp = lnb + 8 * fq; const float* gpp = (isq ? qg : (isk ? kg : lng)) + 8 * fq; asm volatile("" : "+v"(lbp), "+v"(gpp));
#pragma unroll
                for (int e = 0; e < 8; ++e) { const float yl = vl[e] * rs * gpp[e] + (isk ? 0.f : lbp[e]), yh = vh[e] * rs * gpp[32 + e] + (isk ? 0.f : lbp[32 + e]); float sn, cs; sincos_ang(posf * fr8[e], sn, cs);
                    ol[e] = yl * cs - yh * sn; oh[e] = yh * cs + yl * sn; }
                v4u wl, wh; wl.x = pk2(ol[0], ol[1]); wl.y = pk2(ol[2], ol[3]); wl.z = pk2(ol[4], ol[5]); wl.w = pk2(ol[6], ol[7]);
                wh.x = pk2(oh[0], oh[1]); wh.y = pk2(oh[2], oh[3]); wh.z = pk2(oh[4], oh[5]); wh.w = pk2(oh[6], oh[7]);
                if (isq) { bf16* qp = O + (size_t)row * ldc + u.pn * 256 + wc * 64 + 8 * fq; *(v4u*)qp = wl; *(v4u*)(qp + 32) = wh; }
                else if (isk) { bf16* kp = Kb + (size_t)row * 256 + wc * 64 + 8 * fq; *(v4u*)kp = wl; *(v4u*)(kp + 32) = wh; }
                else { const int sq = row & (T - 1);
                    bf16* kp = KIb + (size_t)(row - sq) * 64 + (sq >> 5) * 2048 + (sq & 31) * 8;
                    const int dl = 8 * fq, dh = 32 + 8 * fq;
                    *(v4u*)(kp + (dl >> 4) * 512 + ((dl >> 3) & 1) * 256) = wl; *(v4u*)(kp + (dh >> 4) * 512 + ((dh >> 3) & 1) * 256) = wh; }
            }
    }
};
struct EpiStore {
    static constexpr bool PERM = true, AFTER_DRAIN = false;
    bf16* O; int ldc;
    __device__ __forceinline__ void operator()(const pg8::f32x4 (&acc)[2][2][4][2], const pg8::Unit& u, int wr, int wc, int fr, int fq) const {
        const int row0 = u.pm * 256 + wr * 64 + fr, col0 = u.pn * 256 + wc * 32 + 8 * fq;
#pragma unroll
        for (int ai = 0; ai < 2; ++ai)
#pragma unroll
            for (int m = 0; m < 4; ++m) { bf16* rowp = O + (size_t)(row0 + ai * 128 + m * 16) * ldc + col0;
#pragma unroll
                for (int bj = 0; bj < 2; ++bj) { const pg8::f32x4 v0 = acc[ai][bj][m][0], v1 = acc[ai][bj][m][1];
                    v4u w; w.x = pk2(v0[0], v0[1]); w.y = pk2(v0[2], v0[3]); w.z = pk2(v1[0], v1[1]); w.w = pk2(v1[2], v1[3]);
                    *(v4u*)(rowp + bj * 128) = w; } }
    }
};
template <bool XIN_BF16, bool OUT_BF16> struct EpiResid {
    static constexpr bool PERM = true, AFTER_DRAIN = false;
    const void* xin; void* out; const float* gate;
    __device__ __forceinline__ void operator()(const pg8::f32x4 (&acc)[2][2][4][2], const pg8::Unit& u, int wr, int wc, int fr, int fq) const {
        const int row0 = u.pm * 256 + wr * 64 + fr, col0 = u.pn * 256 + wc * 32 + 8 * fq;
        const float* gp = gate + (size_t)((u.pm * 256) >> 13) * 6144 + col0;
        f32x4 gv[2][2];
#pragma unroll
        for (int bj = 0; bj < 2; ++bj)
#pragma unroll
            for (int n = 0; n < 2; ++n) gv[bj][n] = *(const f32x4*)(gp + bj * 128 + 4 * n);
#pragma unroll
        for (int ai = 0; ai < 2; ++ai)
#pragma unroll
            for (int m = 0; m < 4; ++m) { const size_t rb = (size_t)(row0 + ai * 128 + m * 16) * D + col0;
#pragma unroll
                for (int bj = 0; bj < 2; ++bj) { f32x4 x0, x1;
                    if (XIN_BF16) { const v4u w = *(const v4u*)((const bf16*)xin + rb + bj * 128);
                        x0 = (f32x4){bf2f(w.x & 0xffffu), bf2f(w.x >> 16), bf2f(w.y & 0xffffu), bf2f(w.y >> 16)}; x1 = (f32x4){bf2f(w.z & 0xffffu), bf2f(w.z >> 16), bf2f(w.w & 0xffffu), bf2f(w.w >> 16)}; }
                    else { x0 = *(const f32x4*)((const float*)xin + rb + bj * 128); x1 = *(const f32x4*)((const float*)xin + rb + bj * 128 + 4); }
                    const f32x4 o0 = x0 + gv[bj][0] * acc[ai][bj][m][0], o1 = x1 + gv[bj][1] * acc[ai][bj][m][1];
                    if (OUT_BF16) { v4u w; w.x = pk2(o0.x, o0.y); w.y = pk2(o0.z, o0.w); w.z = pk2(o1.x, o1.y); w.w = pk2(o1.z, o1.w); *(v4u*)((bf16*)out + rb + bj * 128) = w; }
                    else { *(f32x4*)((float*)out + rb + bj * 128) = o0; *(f32x4*)((float*)out + rb + bj * 128 + 4) = o1; } } }
    }
};
struct EpiConvIn {
    static constexpr bool PERM = true, AFTER_DRAIN = false;
    bf16* Z; bf16* Bg;
    __device__ __forceinline__ void operator()(const pg8::f32x4 (&acc)[2][2][4][2], const pg8::Unit& u, int wr, int wc, int fr, int fq) const {
        const int row0 = u.pm * 256 + wr * 64 + fr;
        if (u.pn < 8) {
            const int ch0 = u.pn * 128 + wc * 32 + 8 * fq;
#pragma unroll
            for (int ai = 0; ai < 2; ++ai)
#pragma unroll
                for (int m = 0; m < 4; ++m) { bf16* rowp = Z + (size_t)(row0 + ai * 128 + m * 16) * D + ch0;
                    const pg8::f32x4 z0 = acc[ai][0][m][0] * acc[ai][1][m][0], z1 = acc[ai][0][m][1] * acc[ai][1][m][1];
                    v4u w; w.x = pk2(z0[0], z0[1]); w.y = pk2(z0[2], z0[3]); w.z = pk2(z1[0], z1[1]); w.w = pk2(z1[2], z1[3]); *(v4u*)rowp = w; }
        } else {
            const int col0 = (u.pn - 8) * 256 + wc * 32 + 8 * fq;
#pragma unroll
            for (int ai = 0; ai < 2; ++ai)
#pragma unroll
                for (int m = 0; m < 4; ++m) { bf16* rowp = Bg + (size_t)(row0 + ai * 128 + m * 16) * D + col0;
#pragma unroll
                    for (int bj = 0; bj < 2; ++bj) { const pg8::f32x4 v0 = acc[ai][bj][m][0], v1 = acc[ai][bj][m][1];
                        v4u w; w.x = pk2(v0[0], v0[1]); w.y = pk2(v0[2], v0[3]); w.z = pk2(v1[0], v1[1]); w.w = pk2(v1[2], v1[3]);
                        *(v4u*)(rowp + bj * 128) = w; } }
        }
    }
};
struct EpiSwiglu {
    static constexpr bool PERM = true, AFTER_DRAIN = false;
    bf16* ACT;
    __device__ __forceinline__ void operator()(const pg8::f32x4 (&acc)[2][2][4][2], const pg8::Unit& u, int wr, int wc, int fr, int fq) const {
        const int row0 = u.pm * 256 + wr * 64 + fr, hid0 = u.pn * 128 + wc * 32 + 8 * fq;
#pragma unroll
        for (int ai = 0; ai < 2; ++ai)
#pragma unroll
            for (int m = 0; m < 4; ++m) { bf16* rowp = ACT + (size_t)(row0 + ai * 128 + m * 16) * FF + hid0; float r[8];
#pragma unroll
                for (int n = 0; n < 2; ++n) { const pg8::f32x4 g = acc[ai][0][m][n], uu = acc[ai][1][m][n];
#pragma unroll
                    for (int e = 0; e < 4; ++e) r[4 * n + e] = g[e] * __builtin_amdgcn_rcpf(1.f + __expf(-g[e])) * uu[e]; }
                v4u w; w.x = pk2(r[0], r[1]); w.y = pk2(r[2], r[3]); w.z = pk2(r[4], r[5]); w.w = pk2(r[6], r[7]);
                *(v4u*)rowp = w; }
    }
};

__device__ __forceinline__ void transpose_item(const float* W, int K, int N, int nblk, bf16* WT, int mode, LAS float* scr, int item, int lane) {
    const int kb = item / nblk, nb = item % nblk, k0 = 64 * kb, n0 = 32 * nb;
    const int ncol = n0 + (lane & 31);
#pragma unroll
    for (int i = 0; i < 32; ++i) { const int kk = 2 * i + (lane >> 5); scr[kk * 33 + (lane & 31)] = (ncol < N) ? W[(size_t)(k0 + kk) * N + ncol] : 0.f; }
    LDS_WAIT();
    const int c = lane & 7;
#pragma unroll
    for (int j = 0; j < 4; ++j) { const int nl = (lane >> 3) + 8 * j, n = n0 + nl; const LAS float* s = scr + (8 * c) * 33 + nl;
        v4u o; o.x = pk2(s[0 * 33], s[1 * 33]); o.y = pk2(s[2 * 33], s[3 * 33]); o.z = pk2(s[4 * 33], s[5 * 33]); o.w = pk2(s[6 * 33], s[7 * 33]);
        int dest;
        if (mode == 0) dest = n;
        else if (mode == 4) { const int tile = n >> 8, o = n & 255; dest = tile * 256 + 128 * ((o >> 5) & 1) + 32 * (o >> 6) + (o & 31); (void)n; }
        else if (mode == 3) { const int j = n & 1023; dest = (n < 1024) ? 2048 + n : (256 * (j >> 7) + (j & 127) + (n >= 2048 ? 128 : 0)); }
        else dest = 256 * (n >> 7) + (n & 127) + (mode == 2 ? 128 : 0);
        *(v4u*)(WT + (size_t)dest * K + k0 + 8 * c) = o; }
    LDS_WAIT();
}

template <bool IN_BF16>
__device__ __forceinline__ void norm_rows(const void* xin, bf16* H, const float* g, const float* modl, int shift_idx, int tid_in) {
    int tid = tid_in; asm volatile("" : "+v"(tid));
    const int lane = tid & 63, gw = blockIdx.x * NWAVES + __builtin_amdgcn_readfirstlane(tid >> 6), ngw = gridDim.x * NWAVES;
    f32x4 vn[4];
#define NR_LOAD(mrow) { _Pragma("unroll") for (int j_ = 0; j_ < 4; ++j_) { \
        if (IN_BF16) { const v2u w_ = ((const v2u*)((const bf16*)xin + (size_t)(mrow) * D) + lane)[64 * j_]; vn[j_] = (f32x4){bf2f(w_.x & 0xffffu), bf2f(w_.x >> 16), bf2f(w_.y & 0xffffu), bf2f(w_.y >> 16)}; } \
        else vn[j_] = ((const f32x4*)((const float*)xin + (size_t)(mrow) * D) + lane)[64 * j_]; } }
    if (gw < M) NR_LOAD(gw)
    for (int m = gw; m < M; m += ngw) {
        const float* sh = modl + (size_t)(m >> 13) * 6144 + shift_idx * 1024; const float* sc = sh + 1024;
        f32x4 v[4]; float ss = 0.f;
#pragma unroll
        for (int j = 0; j < 4; ++j) { v[j] = vn[j]; ss += (v[j].x * v[j].x + v[j].y * v[j].y) + (v[j].z * v[j].z + v[j].w * v[j].w); }
        { const int mn = (m + ngw < M) ? m + ngw : m; NR_LOAD(mn) }
        const float rstd = rsqrtf(wave_sum(ss) * (1.f / D) + EPS);
        v2u* o8 = (v2u*)(H + (size_t)m * D) + lane;
#pragma unroll
        for (int j = 0; j < 4; ++j) { const int col = 4 * lane + 256 * j;
            const f32x4 gg = *(const f32x4*)(g + col), scv = *(const f32x4*)(sc + col), shv = *(const f32x4*)(sh + col);
            const f32x4 y = v[j] * rstd * gg * (scv + 1.f) + shv;
            v2u w; w.x = pk2(y.x, y.y); w.y = pk2(y.z, y.w); o8[64 * j] = w; }
    }
#undef NR_LOAD
}

__device__ __forceinline__ void sincos_ang(float ang, float& s, float& c) {
    double r = (double)ang * 0.15915494309189535; r -= __builtin_rint(r);
    const float rf = (float)r; s = __builtin_amdgcn_sinf(rf); c = __builtin_amdgcn_cosf(rf);
}
__device__ __forceinline__ unsigned fkey(float f) { const unsigned u = __builtin_bit_cast(unsigned, f); return (u & 0x80000000u) ? ~u : (u | 0x80000000u); }

#ifdef PROBE_ATOM2
#define PROBE_ATOM_EXTRA { LAS unsigned* dq_ = (LAS unsigned*)(lds + 155648) + hf * 1024; lds_add(dq_ + (b0_ >> 1), 1u); lds_add(dq_ + (b1_ >> 1), 1u); }
#else
#define PROBE_ATOM_EXTRA
#endif
constexpr int S_KEYS = 0, S_HIST = 131072, S_SEL = 147456, S_TIE = 149504, S_ST = 153600;
__device__ __forceinline__ unsigned lds_add(LAS unsigned* p, unsigned v) { return __hip_atomic_fetch_add(p, v, __ATOMIC_RELAXED, __HIP_MEMORY_SCOPE_WORKGROUP); }

template <int PASS>
__device__ __forceinline__ void radix_pass(LAS unsigned char* lds, int tid, int wave, int lane, int nchunk  ) {
    constexpr int SHIFT = PASS == 0 ? 21 : (PASS == 1 ? 10 : 0);
    constexpr int BITS = PASS == 2 ? 10 : 11, NBIN = 1 << BITS, PER = NBIN / 64, HISHIFT = (SHIFT + BITS) & 31;
    LAS unsigned* hist = (LAS unsigned*)(lds + S_HIST);
    LAS unsigned* st = (LAS unsigned*)(lds + S_ST);
    if (PASS != 0) { for (int i = tid; i < 1024; i += NTHR) ((LAS v4u*)hist)[i] = (v4u){0u, 0u, 0u, 0u}; }
    __syncthreads();
    if (PASS != 0) {
        const int q = wave >> 1; const unsigned pf = st[q * 8];
        LAS unsigned* hq = hist + q * 1024;
        const LAS v4u* kq = (const LAS v4u*)(lds + S_KEYS + q * 32768);
        for (int c = (wave & 1) * 64 + lane; c < nchunk; c += 128) {
            const v4u k = kq[c];
#pragma unroll
            for (int e = 0; e < 4; ++e) { const unsigned key = k[e];
                if (PASS == 0 ? (key != 0u) : ((key >> HISHIFT) == pf)) { const unsigned bin = (key >> SHIFT) & (NBIN - 1); lds_add(hq + (bin >> 1), 1u << (16 * (bin & 1))); } }
        }
    }
    __syncthreads();
    if (wave < 4) {
        const int q = wave; const unsigned need = st[q * 8 + 1];
        const LAS unsigned* hw = hist + q * 1024 + lane * (PER / 2);
        unsigned s = 0;
#pragma unroll
        for (int e = 0; e < PER / 2; ++e) { const unsigned w = hw[e]; s += (w & 0xffffu) + (w >> 16); }
        unsigned incl = s;
#pragma unroll
        for (int d = 1; d < 64; d <<= 1) { const unsigned o = __shfl_down(incl, d); if (lane + d < 64) incl += o; }
        const unsigned above = incl - s;
        if (PASS == 0) {
            const bool own = above < need && need <= incl;
            const unsigned long long bm = __ballot(own); const int ol = bm ? (int)__builtin_ctzll(bm) : 0;
            const unsigned above_o = (unsigned)__shfl((int)above, ol);
            unsigned hb = 0u;
            if (lane < 32) { const unsigned w = hist[q * 1024 + ol * 16 + (lane >> 1)]; hb = (lane & 1) ? (w >> 16) : (w & 0xffffu); }
            unsigned incl2 = hb;
#pragma unroll
            for (int d = 1; d < 32; d <<= 1) { const unsigned o = __shfl_down(incl2, d); if (lane + d < 32) incl2 += o; }
            const unsigned above2 = above_o + incl2 - hb;
            if (lane < 32 && above2 < need && need <= above2 + hb) { st[q * 8 + 0] = (unsigned)(ol * 32 + lane); st[q * 8 + 1] = need - above2; st[q * 8 + 4] = hb; }
        } else
        if (above < need && need <= incl) {
            unsigned cum = above; int bin = PER - 1; unsigned h = 0;
#pragma unroll 1
            for (;; --bin) { const unsigned w = hw[bin >> 1]; h = (bin & 1) ? (w >> 16) : (w & 0xffffu); if (cum + h >= need || bin == 0) break; cum += h; }
            st[q * 8 + 0] = (PASS == 0 ? 0u : (st[q * 8 + 0] << BITS)) | (unsigned)(lane * PER + bin);
            st[q * 8 + 1] = need - cum;
            st[q * 8 + 4] = h;
        }
    }
    __syncthreads();
}

__device__ __forceinline__ void select_phase(const Params& p, LAS unsigned char* lds, const bf16* PROJ, const bf16* KIb, const float* WIb, unsigned short* SEL, int tid_in) {
    const int G = gridDim.x, cid = blockIdx.x;
    LAS unsigned* st = (LAS unsigned*)(lds + S_ST);
    LAS unsigned short* sel = (LAS unsigned short*)(lds + S_SEL);
    LAS unsigned short* tie = (LAS unsigned short*)(lds + S_TIE);
#define UNIT_DECODE(round_, ok_, b_, t0_) { int ul_; \
    if ((G & 7) == 0) { const int x_ = cid & 7, nl_ = G >> 2, lw_ = (x_ & 1) * (G >> 3) + (cid >> 3); \
        b_ = x_ >> 1; ul_ = (round_) * nl_ + (((round_) & 1) ? (nl_ - 1 - lw_) : lw_); ok_ = ul_ < 1984; } \
    else { const int u_ = (round_) * G + (((round_) & 1) ? (G - 1 - cid) : cid); ok_ = u_ < 4 * 1984; b_ = u_ / 1984; ul_ = u_ % 1984; } \
    t0_ = ul_ * 4 + 256; }
#define AFR_LOAD(b_, t0_) { const size_t mb_ = (size_t)(b_) * T + (t0_); const int r_ = lane & 31, hf_ = lane >> 5; \
    { const int ii = r_ >> 3, hh = (r_ >> 2) & 1, jj = r_ & 3; const int q = 2 * hh + (ii >> 1), h = 4 * (ii & 1) + jj; \
      const bf16* qp = PROJ + (mb_ + q) * NATTP + 1536 + h * 64 + 8 * hf_;     \
      _Pragma("unroll") for (int ks = 0; ks < 4; ++ks) Afr[ks] = *(const bf16x8*)(qp + 16 * ks); afr_pos = p.pos[mb_ + q]; } \
    _Pragma("unroll") for (int ql = 0; ql < 2; ++ql) { const f32x4 a = *(const f32x4*)(WIb + (mb_ + 2 * hf_ + ql) * 8), c = *(const f32x4*)(WIb + (mb_ + 2 * hf_ + ql) * 8 + 4); \
        wq[ql][0] = a.x; wq[ql][1] = a.y; wq[ql][2] = a.z; wq[ql][3] = a.w; wq[ql][4] = c.x; wq[ql][5] = c.y; wq[ql][6] = c.z; wq[ql][7] = c.w; } }
    bf16x8 Afr[4]; float wq[2][8]; int afr_pos = 0;
#define AFR_ROPE() { const float posf_ = (float)afr_pos; const int hf_ = lane >> 5; \
    _Pragma("unroll") for (int ks = 0; ks < 2; ++ks) { const v4u lo_ = __builtin_bit_cast(v4u, Afr[ks]), hi_ = __builtin_bit_cast(v4u, Afr[ks + 2]); v4u ol_, oh_; \
        _Pragma("unroll") for (int w_ = 0; w_ < 4; ++w_) { const unsigned lw_ = lo_[w_], hw_ = hi_[w_]; float ro_[2][2]; \
            _Pragma("unroll") for (int z_ = 0; z_ < 2; ++z_) { const float xl_ = z_ ? bf2f(lw_ >> 16) : bf2f(lw_ & 0xffffu), xh_ = z_ ? bf2f(hw_ >> 16) : bf2f(hw_ & 0xffffu); \
                float sn_, cs_; sincos_ang(posf_ * p.inv_freq[16 * ks + 8 * hf_ + 2 * w_ + z_], sn_, cs_); ro_[0][z_] = xl_ * cs_ - xh_ * sn_; ro_[1][z_] = xh_ * cs_ + xl_ * sn_; } \
            ol_[w_] = pk2(ro_[0][0], ro_[0][1]); oh_[w_] = pk2(ro_[1][0], ro_[1][1]); } \
        Afr[ks] = __builtin_bit_cast(bf16x8, ol_); Afr[ks + 2] = __builtin_bit_cast(bf16x8, oh_); } }
    bool ok_n; int b_n, t0_n;
    UNIT_DECODE(0, ok_n, b_n, t0_n)
    { int tid = tid_in; asm volatile("" : "+v"(tid)); const int lane = tid & 63; if (ok_n) AFR_LOAD(b_n, t0_n) }
    for (int round = 0;; ++round) {
        int tid = tid_in; asm volatile("" : "+v"(tid));
        const int lane = tid & 63, wave = __builtin_amdgcn_readfirstlane(tid >> 6);
        if (!ok_n) break;
        const int b = b_n, t0 = t0_n; const size_t mbase = (size_t)b * T + t0;
        const int ntiles = ((t0 + 3) >> 5) + 1, nround = (ntiles + 31) & ~31;
        for (int i = tid; i < 1024; i += NTHR) ((LAS v4u*)(lds + S_HIST))[i] = (v4u){0u, 0u, 0u, 0u};
        if (tid < 4) { st[tid * 8 + 0] = 0u; st[tid * 8 + 1] = 256u; st[tid * 8 + 2] = 0u; st[tid * 8 + 3] = 0u; st[tid * 8 + 5] = 0u; st[tid * 8 + 6] = 0u; }
        __syncthreads();
#ifdef PROBE_IDX2
        for (int rep_ = 0; rep_ < 2; ++rep_)
#endif
        {
            const int r = lane & 31, hf = lane >> 5;
            const int tA = t0 + 2 * hf;
            const bf16* kbase = KIb + (size_t)b * T * 64 + lane * 8;
            LAS unsigned* kw0 = (LAS unsigned*)(lds + S_KEYS + (2 * hf) * 32768) + r; LAS unsigned* kw1 = kw0 + 8192;
            LAS unsigned* hq0 = (LAS unsigned*)(lds + S_HIST) + (2 * hf) * 1024; LAS unsigned* hdum = (LAS unsigned*)(lds + S_ST + 128) + lane;
            bf16x8 R0[4], R1[4], R2[4], R3[4];
#define IDX_LOAD(R, ktv) { const int ktc_ = (ktv) < ntiles ? (ktv) : (ntiles - 1); const bf16* kp_ = kbase + (size_t)ktc_ * 2048; \
    R[0] = *(const bf16x8*)(kp_); R[1] = *(const bf16x8*)(kp_ + 512); R[2] = *(const bf16x8*)(kp_ + 1024); R[3] = *(const bf16x8*)(kp_ + 1536); }
#define IDX_MMA(ACC, R, ktv) if ((ktv) < ntiles) { _Pragma("unroll") for (int e_ = 0; e_ < 16; ++e_) ACC[e_] = 0.f; \
    ACC = __builtin_amdgcn_mfma_f32_32x32x16_bf16(Afr[0], R[0], ACC, 0, 0, 0); ACC = __builtin_amdgcn_mfma_f32_32x32x16_bf16(Afr[1], R[1], ACC, 0, 0, 0); \
    ACC = __builtin_amdgcn_mfma_f32_32x32x16_bf16(Afr[2], R[2], ACC, 0, 0, 0); ACC = __builtin_amdgcn_mfma_f32_32x32x16_bf16(Afr[3], R[3], ACC, 0, 0, 0); }
#define IDX_POST(ACC, ktv) if ((ktv) >= 0 && (ktv) < ntiles) { float s0_ = 0.f, s1_ = 0.f; \
    _Pragma("unroll") for (int i4_ = 0; i4_ < 4; ++i4_) _Pragma("unroll") for (int j_ = 0; j_ < 4; ++j_) { const float a_ = ACC[4 * i4_ + j_]; const int vi_ = __float_as_int(a_); const float v_ = __int_as_float(vi_ > 0 ? vi_ : 0); const int h_ = 4 * (i4_ & 1) + j_; \
        if (i4_ >> 1) s1_ = __builtin_fmaf(wq[1][h_], v_, s1_); else s0_ = __builtin_fmaf(wq[0][h_], v_, s0_); } \
    const int s_ = 32 * (ktv) + r; const unsigned k0_ = (s_ <= tA) ? fkey(s0_) : 0u, k1_ = (s_ <= tA + 1) ? fkey(s1_) : 0u; kw0[32 * (ktv)] = k0_; kw1[32 * (ktv)] = k1_; \
    { const unsigned b0_ = k0_ >> 21, b1_ = k1_ >> 21; \
      lds_add(k0_ ? hq0 + (b0_ >> 1) : hdum, k0_ ? (1u << (16 * (b0_ & 1))) : 0u); lds_add(k1_ ? hq0 + 1024 + (b1_ >> 1) : hdum, k1_ ? (1u << (16 * (b1_ & 1))) : 0u); } }
            f32x16 accA, accB;
#pragma unroll
            for (int e = 0; e < 16; ++e) { accA[e] = 0.f; accB[e] = 0.f; }
            __builtin_amdgcn_sched_barrier(0); IDX_LOAD(R0, wave) __builtin_amdgcn_sched_barrier(0); IDX_LOAD(R1, wave + 8) __builtin_amdgcn_sched_barrier(0); IDX_LOAD(R2, wave + 16) __builtin_amdgcn_sched_barrier(0);
            int kt = wave;
            for (; kt < nround; kt += 32) {
                IDX_LOAD(R3, kt + 24) __builtin_amdgcn_sched_barrier(0); IDX_MMA(accA, R0, kt) IDX_POST(accB, kt - 8) __builtin_amdgcn_sched_barrier(0);
                IDX_LOAD(R0, kt + 32) __builtin_amdgcn_sched_barrier(0); IDX_MMA(accB, R1, kt + 8) IDX_POST(accA, kt) __builtin_amdgcn_sched_barrier(0);
                IDX_LOAD(R1, kt + 40) __builtin_amdgcn_sched_barrier(0); IDX_MMA(accA, R2, kt + 16) IDX_POST(accB, kt + 8) __builtin_amdgcn_sched_barrier(0);
                IDX_LOAD(R2, kt + 48) __builtin_amdgcn_sched_barrier(0); IDX_MMA(accB, R3, kt + 24) IDX_POST(accA, kt + 16) __builtin_amdgcn_sched_barrier(0);
            }
            IDX_POST(accB, kt - 8)
#undef IDX_MMA
#undef IDX_POST
#undef IDX_LOAD
        }
        UNIT_DECODE(round + 1, ok_n, b_n, t0_n)
        if (ok_n) AFR_LOAD(b_n, t0_n)
        const int nchunk = ntiles * 8;
        radix_pass<0>(lds, tid, wave, lane, nchunk);
#ifdef PROBE_RAD2
        if (tid < 4) { st[tid * 8 + 0] = 0u; st[tid * 8 + 1] = 256u; }
        radix_pass<0>(lds, tid, wave, lane, nchunk);
#endif
        LAS unsigned* ckey = (LAS unsigned*)(lds + S_HIST); LAS unsigned short* cidx = (LAS unsigned short*)(lds + S_HIST + 8192); LAS unsigned* shist = (LAS unsigned*)(lds + S_HIST + 12288);
        {
            const int q = wave >> 1; const unsigned Bq = st[q * 8];
            const LAS v4u* kq = (const LAS v4u*)(lds + S_KEYS + q * 32768);
            unsigned cnt = 0u;
            for (int c = (wave & 1) * 64 + lane; c < nchunk; c += 128) {
                const v4u k = kq[c];
#pragma unroll
                for (int e = 0; e < 4; ++e) { const unsigned bin = k[e] >> 21; cnt += (bin > Bq ? 1u : 0u) + (bin == Bq ? 0x10000u : 0u); }
            }
            unsigned incl = cnt;
#pragma unroll
            for (int d = 1; d < 64; d <<= 1) { const unsigned o = __shfl_up(incl, d); if (lane >= d) incl += o; }
            const unsigned excl = incl - cnt, tot = (unsigned)__shfl((int)incl, 63);
            unsigned baseA = 0u, baseC = 0u;
            if (lane == 0) { baseA = lds_add(&st[q * 8 + 2], tot & 0xffffu); baseC = lds_add(&st[q * 8 + 5], tot >> 16); }
            baseA = (unsigned)__shfl((int)baseA, 0); baseC = (unsigned)__shfl((int)baseC, 0);
            unsigned pa = baseA + (excl & 0xffffu), pc = baseC + (excl >> 16);
            for (int c = (wave & 1) * 64 + lane; c < nchunk; c += 128) {
                const v4u k = kq[c];
#pragma unroll
                for (int e = 0; e < 4; ++e) { const unsigned key = k[e]; const unsigned bin = key >> 21; const unsigned short s = (unsigned short)(4 * c + e);
                    if (bin > Bq) { sel[q * 256 + (pa & 255u)] = s; ++pa; }
                    else if (bin == Bq) { if (pc < 512u) { ckey[q * 512 + pc] = key; cidx[q * 512 + pc] = s; } ++pc; } }
            }
        }
        __syncthreads();
        const bool small = st[4] <= 512u && st[12] <= 512u && st[20] <= 512u && st[28] <= 512u;
        if (small) {
            if (wave < 4) {
                const int q = wave; const int n = (int)st[q * 8 + 5]; unsigned need = st[q * 8 + 1], cpf = 0u, cnt_eq = 0u;
                LAS unsigned* sh = shist + q * 128;
#pragma unroll
                for (int ps = 0; ps < 3; ++ps) {
                    const int shift = 14 - 7 * ps;
#define WAVE_LDS_FENCE() { __builtin_amdgcn_fence(__ATOMIC_SEQ_CST, "workgroup"); __builtin_amdgcn_wave_barrier(); }
                    WAVE_LDS_FENCE()
                    sh[2 * lane] = 0u; sh[2 * lane + 1] = 0u;
                    WAVE_LDS_FENCE()
                    for (int i = lane; i < n; i += 64) { const unsigned low = ckey[q * 512 + i] & 0x1fffffu;
                        if (ps == 0 || (low >> (shift + 7)) == cpf) lds_add(sh + ((low >> shift) & 127u), 1u); }
                    WAVE_LDS_FENCE()
                    const unsigned h0 = sh[2 * lane], h1 = sh[2 * lane + 1];
                    const unsigned sm = h0 + h1; unsigned incl = sm;
#pragma unroll
                    for (int d = 1; d < 64; d <<= 1) { const unsigned o = __shfl_down(incl, d); if (lane + d < 64) incl += o; }
                    const unsigned above = incl - sm;
                    const bool own = above < need && need <= incl;
                    const unsigned long long bm = __ballot(own); const int ol = bm ? (int)__builtin_ctzll(bm) : 0;
                    const bool top = above + h1 >= need;
                    const unsigned nbin = (unsigned)(2 * lane + (top ? 1 : 0)), nneed = need - (top ? above : above + h1), neq = top ? h1 : h0;
                    cpf = (cpf << 7) | (unsigned)__shfl((int)nbin, ol); need = (unsigned)__shfl((int)nneed, ol); cnt_eq = (unsigned)__shfl((int)neq, ol);
                }
                const unsigned Tq = (st[q * 8] << 21) | cpf; const bool allq = need == cnt_eq;
                for (int i = lane; i < n; i += 64) { const unsigned key = ckey[q * 512 + i];
                    if (key >= Tq) { const unsigned short s2 = cidx[q * 512 + i];
                        if (key > Tq || allq) { const unsigned pos = lds_add(&st[q * 8 + 2], 1u); sel[q * 256 + (pos & 255u)] = s2; }
                        else { const unsigned pos = lds_add(&st[q * 8 + 3], 1u); if (pos < 512u) tie[q * 512 + pos] = s2; } } }
                if (lane == 0) st[q * 8 + 1] = need;
            }
        } else {
            if (tid < 4) st[tid * 8 + 2] = 0u;
            radix_pass<1>(lds, tid, wave, lane, nchunk);
            radix_pass<2>(lds, tid, wave, lane, nchunk);
            {
                const int q = wave >> 1; const unsigned Tq = st[q * 8]; const bool allq = st[q * 8 + 1] == st[q * 8 + 4];
                const LAS v4u* kq = (const LAS v4u*)(lds + S_KEYS + q * 32768);
                for (int c = (wave & 1) * 64 + lane; c < nchunk; c += 128) {
                    const v4u k = kq[c];
    #pragma unroll
                    for (int e = 0; e < 4; ++e) { const unsigned key = k[e];
                        if (key >= Tq) { const unsigned short s = (unsigned short)(4 * c + e);
                            if (key > Tq || allq) { const unsigned pos = lds_add(&st[q * 8 + 2], 1u); sel[q * 256 + (pos & 255u)] = s; }
                            else { const unsigned pos = lds_add(&st[q * 8 + 3], 1u); if (pos < 512u) tie[q * 512 + pos] = s; } } }
                }
            }
        }
        __syncthreads();
        if (wave < 4) {
            const int q = wave; unsigned ntie = st[q * 8 + 3]; ntie = ntie < 512u ? ntie : 512u;
            if (ntie > 0u) { const unsigned need_eq = st[q * 8 + 1];
                for (unsigned e = lane; e < ntie; e += 64) { const unsigned my = tie[q * 512 + e]; unsigned rank = 0;
                    for (unsigned f = 0; f < ntie; ++f) rank += (tie[q * 512 + f] < my) ? 1u : 0u;
                    if (rank < need_eq) { const unsigned pos = lds_add(&st[q * 8 + 2], 1u); sel[q * 256 + (pos & 255u)] = (unsigned short)my; } } }
        }
        __syncthreads();
        ((unsigned*)(SEL + mbase * 256))[tid] = ((const LAS unsigned*)sel)[tid];
        __syncthreads();
    }
#undef UNIT_DECODE
#undef AFR_LOAD
#undef AFR_ROPE
}

typedef short v4i16_t __attribute__((ext_vector_type(4)));
__device__ __forceinline__ void gather_attn_phase(const Params& p, LAS unsigned char* lds, const bf16* PROJ, const bf16* Kb, const bf16* Vb, const unsigned short* SEL, bf16* Ob, int tid_in) {
    int tid = tid_in; asm volatile("" : "+v"(tid));
    const int lane = tid & 63, wave = __builtin_amdgcn_readfirstlane(tid >> 6);
    const int G = gridDim.x, ngroups = (G & 7) ? 1 : 8;
    const int x = blockIdx.x % ngroups, wix = (blockIdx.x / ngroups) * NWAVES + wave, nwx = (G / ngroups) * NWAVES;
    LAS unsigned char* img = lds + wave * 16384;
    LAS unsigned short* slb0 = (LAS unsigned short*)(lds + 131072 + wave * 1024); LAS unsigned short* slb1 = slb0 + 256;
    const int n16 = lane & 15, kg = lane >> 4, vrow = lane >> 3, vch = lane & 7;
    const int qq = (lane & 15) >> 2, pp = lane & 3;
    unsigned roff[4][2], kroff[2][2], klc[4], vlc[4];
#pragma unroll
    for (int i = 0; i < 4; ++i) { const int row = 8 * i + vrow; klc[i] = 16 * (vch ^ ((row ^ (row >> 3)) & 7)); vlc[i] = 16 * (2 * ((vch >> 1) ^ ((row >> 1) & 3)) + (vch & 1)); }
#pragma unroll
    for (int c = 0; c < 4; ++c)
#pragma unroll
        for (int tt = 0; tt < 2; ++tt) { const int row = 16 * tt + 4 * kg + qq; roff[c][tt] = 4096 + row * 128 + 32 * (c ^ ((row >> 1) & 3)) + 8 * pp; }
#pragma unroll
    for (int blk = 0; blk < 2; ++blk)
#pragma unroll
        for (int ks = 0; ks < 2; ++ks) { const int row = 16 * blk + n16; kroff[blk][ks] = row * 128 + 16 * ((kg + 4 * ks) ^ ((row ^ (row >> 3)) & 7)); }
    const int nq = (T - wix + nwx - 1) / nwx, npair = (16 - x + ngroups - 1) / ngroups, ntask = nq * npair;
    if (ntask <= 0) return;
#define TASK(i_, b_, g_, t_) const int pi_##b_ = x + ngroups * ((i_) / nq); const int b_ = pi_##b_ >> 2, g_ = pi_##b_ & 3, t_ = wix + nwx * ((i_) % nq);
#define SEL_LOAD(sv_, b_, t_) { v2u ld_ = *(const v2u*)(SEL + ((size_t)(b_) * T + (t_)) * 256 + 4 * lane); \
    v2u id_; id_.x = (unsigned)(4 * lane) | ((unsigned)(4 * lane + 1) << 16); id_.y = (unsigned)(4 * lane + 2) | ((unsigned)(4 * lane + 3) << 16); \
    sv_.x = (t_) >= 256 ? ld_.x : id_.x; sv_.y = (t_) >= 256 ? ld_.y : id_.y; }
#define Q_RAW(rq_, pos_, b_, g_, t_) { const size_t mq_ = (size_t)(b_) * T + (t_); const bf16* qp_ = PROJ + mq_ * NATTP + (4 * (g_) + (n16 & 3)) * 64 + 8 * kg; \
    rq_[0] = *(const v4u*)qp_; rq_[1] = *(const v4u*)(qp_ + 32); }
#define Q_FINISH(Bq_, rq_, pos_) { const v4u z_ = {0u, 0u, 0u, 0u}; (void)(pos_); Bq_[0] = __builtin_bit_cast(bf16x8, (n16 < 4) ? rq_[0] : z_); Bq_[1] = __builtin_bit_cast(bf16x8, (n16 < 4) ? rq_[1] : z_); }
#define SELX(S_, k_) ((int)((S_[(k_) >> 3][((k_) >> 1) & 3] >> (16 * ((k_) & 1))) & 0xffffu))
#define CH_DMA(buf, ch, S_, Kg_, Vg_) { \
    _Pragma("unroll") for (int i_ = 0; i_ < 4; ++i_) { const int sv2_ = SELX(S_, (ch) * 4 + i_); \
        __builtin_amdgcn_global_load_lds((const unsigned*)((Kg_) + (size_t)sv2_ * 512 + klc[i_]), (LAS unsigned*)(img + (buf) * 8192 + i_ * 1024), 16, 0, 0); \
        __builtin_amdgcn_global_load_lds((const unsigned*)((Vg_) + (size_t)sv2_ * 512 + vlc[i_]), (LAS unsigned*)(img + (buf) * 8192 + 4096 + i_ * 1024), 16, 0, 0); } }
#define SEL_REGS(S_, slp_) { _Pragma("unroll") for (int j_ = 0; j_ < 4; ++j_) S_[j_] = ((const LAS v4u*)((slp_) + vrow * 32))[j_]; }
    v4u selc[4], seln[4]; v4u rqn[2]; int posn = 0;
    float qgl[8], qgh[8], qinvf[8];
#pragma unroll
    for (int e = 0; e < 8; ++e) { qgl[e] = p.qg[8 * kg + e]; qgh[e] = p.qg[32 + 8 * kg + e]; qinvf[e] = p.inv_freq[8 * kg + e]; }
    bf16x8 Bq[2], Bqn[2]; v2u svn;
    {
        TASK(0, b0, g0, t0)
        SEL_LOAD(svn, b0, t0) *(LAS v2u*)(slb0 + 4 * lane) = svn;
        Q_RAW(rqn, posn, b0, g0, t0) Q_FINISH(Bq, rqn, posn)
        const char* Kg0 = (const char*)(Kb + (size_t)b0 * T * 256 + g0 * 64); const char* Vg0 = (const char*)(Vb + (size_t)b0 * T * 256 + g0 * 64);
        asm volatile("s_waitcnt lgkmcnt(0)" ::: "memory");
        SEL_REGS(selc, slb0)
        CH_DMA(0, 0, selc, Kg0, Vg0)
    }
    for (int i = 0; i < ntask; ++i) {
        LAS unsigned short* slc = (i & 1) ? slb1 : slb0; LAS unsigned short* sln = (i & 1) ? slb0 : slb1;
        TASK(i, b, g, t)
        const int inx = (i + 1 < ntask) ? i + 1 : i;
        TASK(inx, bn, gn, tn)
        const char* Kg = (const char*)(Kb + (size_t)b * T * 256 + g * 64); const char* Vg = (const char*)(Vb + (size_t)b * T * 256 + g * 64);
        const char* Kgn = (const char*)(Kb + (size_t)bn * T * 256 + gn * 64); const char* Vgn = (const char*)(Vb + (size_t)bn * T * 256 + gn * 64);
        const size_t m = (size_t)b * T + t;
        const int nsel = t < 255 ? t + 1 : 256;
        f32x4 Oacc[4];
#pragma unroll
        for (int c = 0; c < 4; ++c) Oacc[c] = (f32x4){0.f, 0.f, 0.f, 0.f};
        float lsum = 0.f;
#pragma unroll
        for (int ch = 0; ch < 8; ++ch) {
            if (ch == 0) { SEL_LOAD(svn, bn, tn) Q_RAW(rqn, posn, bn, gn, tn) }
            if (ch == 5) Q_FINISH(Bqn, rqn, posn)
            if (ch == 4) *(LAS v2u*)(sln + 4 * lane) = svn;
            if (ch == 6) { asm volatile("s_waitcnt lgkmcnt(0)" ::: "memory"); SEL_REGS(seln, sln) }
            if (ch < 7) CH_DMA((ch + 1) & 1, ch + 1, selc, Kg, Vg) else CH_DMA(0, 0, seln, Kgn, Vgn)
            asm volatile("s_waitcnt vmcnt(8)" ::: "memory");
            const int cb = ch & 1;
            LAS unsigned char* kst = img + cb * 8192; LAS unsigned char* vst = kst;
            const bf16x8 Ka0 = *(const LAS bf16x8*)(kst + kroff[0][0]), Ka1 = *(const LAS bf16x8*)(kst + kroff[0][1]), Ka2 = *(const LAS bf16x8*)(kst + kroff[1][0]), Ka3 = *(const LAS bf16x8*)(kst + kroff[1][1]);
            __builtin_amdgcn_sched_barrier(0);
            f32x4 S0 = {0.f, 0.f, 0.f, 0.f}, S1 = {0.f, 0.f, 0.f, 0.f};
            S0 = __builtin_amdgcn_mfma_f32_16x16x32_bf16(Ka0, Bq[0], S0, 0, 0, 0); S0 = __builtin_amdgcn_mfma_f32_16x16x32_bf16(Ka1, Bq[1], S0, 0, 0, 0);
            S1 = __builtin_amdgcn_mfma_f32_16x16x32_bf16(Ka2, Bq[0], S1, 0, 0, 0); S1 = __builtin_amdgcn_mfma_f32_16x16x32_bf16(Ka3, Bq[1], S1, 0, 0, 0);
            float p0[4], p1[4];
#pragma unroll
            for (int jj = 0; jj < 4; ++jj) { const int r0 = 4 * kg + jj, r1 = 16 + 4 * kg + jj;
                const int j0 = (r0 & 7) * 32 + ch * 4 + (r0 >> 3), j1 = (r1 & 7) * 32 + ch * 4 + (r1 >> 3);
                p0[jj] = (j0 < nsel) ? __expf(S0[jj]) : 0.f; p1[jj] = (j1 < nsel) ? __expf(S1[jj]) : 0.f; lsum += p0[jj] + p1[jj]; }
            v4u aw; aw.x = pk2(p0[0], p0[1]); aw.y = pk2(p0[2], p0[3]); aw.z = pk2(p1[0], p1[1]); aw.w = pk2(p1[2], p1[3]);
            const bf16x8 Ap = __builtin_bit_cast(bf16x8, aw);
            {
                v2u tr[4][2]; const unsigned vb = (unsigned)(__UINTPTR_TYPE__)vst;
                asm volatile("ds_read_b64_tr_b16 %0, %8\n\tds_read_b64_tr_b16 %1, %9\n\tds_read_b64_tr_b16 %2, %10\n\tds_read_b64_tr_b16 %3, %11\n\t"
                             "ds_read_b64_tr_b16 %4, %12\n\tds_read_b64_tr_b16 %5, %13\n\tds_read_b64_tr_b16 %6, %14\n\tds_read_b64_tr_b16 %7, %15\n\ts_waitcnt lgkmcnt(0)"
                             : "=&v"(tr[0][0]), "=&v"(tr[0][1]), "=&v"(tr[1][0]), "=&v"(tr[1][1]), "=&v"(tr[2][0]), "=&v"(tr[2][1]), "=&v"(tr[3][0]), "=&v"(tr[3][1])
                             : "v"(vb + roff[0][0]), "v"(vb + roff[0][1]), "v"(vb + roff[1][0]), "v"(vb + roff[1][1]), "v"(vb + roff[2][0]), "v"(vb + roff[2][1]), "v"(vb + roff[3][0]), "v"(vb + roff[3][1])
                             : "memory");
#pragma unroll
                for (int c = 0; c < 4; ++c) { v4u bw; bw.x = tr[c][0].x; bw.y = tr[c][0].y; bw.z = tr[c][1].x; bw.w = tr[c][1].y;
                    Oacc[c] = __builtin_amdgcn_mfma_f32_16x16x32_bf16(Ap, __builtin_bit_cast(bf16x8, bw), Oacc[c], 0, 0, 0); }
            }
        }
        Bq[0] = Bqn[0]; Bq[1] = Bqn[1];
#pragma unroll
        for (int j = 0; j < 4; ++j) selc[j] = seln[j];
        lsum += __shfl_xor(lsum, 16); lsum += __shfl_xor(lsum, 32);
        float linv[4];
#pragma unroll
        for (int j = 0; j < 4; ++j) linv[j] = 1.f / __shfl(lsum, j);
        if (lane < 16) {
#pragma unroll
            for (int c = 0; c < 4; ++c)
#pragma unroll
                for (int j = 0; j < 4; ++j) Ob[m * 1024 + (4 * g + j) * 64 + 16 * c + lane] = (bf16)f2bf(Oacc[c][j] * linv[j]);
        }
    }
#undef TASK
#undef SEL_LOAD
#undef Q_RAW
#undef Q_FINISH
#undef CH_LOAD
}

__device__ __forceinline__ float sum16(float v) { v += __shfl_xor(v, 1); v += __shfl_xor(v, 2); v += __shfl_xor(v, 4); v += __shfl_xor(v, 8); return v; }
__device__ __forceinline__ void rope_phase(const Params& p, const bf16* PROJ, bf16* Qb, bf16* Kb, bf16* Vb, bf16* QIb, bf16* KIb, float* WIb, int tid_in) {
    int tid = tid_in; asm volatile("" : "+v"(tid));
    const int lane = tid & 63, gw = blockIdx.x * NWAVES + __builtin_amdgcn_readfirstlane(tid >> 6), ngw = gridDim.x * NWAVES;
    const int hs = lane >> 4, d4 = lane & 15, d0 = 4 * d4;
    float invf[4], qgl[4], kgl[4], lg[4], lb[4];
#pragma unroll
    for (int e = 0; e < 4; ++e) { invf[e] = p.inv_freq[(d0 + e) & 31]; qgl[e] = p.qg[d0 + e]; kgl[e] = p.kg[d0 + e]; lg[e] = p.lng[d0 + e]; lb[e] = p.lnb[d0 + e]; }
    const float sg = (d4 < 8) ? -1.f : 1.f;
    for (int m = gw; m < M; m += ngw) {
        const float posf = (float)p.pos[m];
        float cs[4], sn[4];
#pragma unroll
        for (int e = 0; e < 4; ++e) { float s_, c_; sincos_ang(posf * invf[e], s_, c_); cs[e] = c_; sn[e] = s_ * sg; }
        const bf16* pr = PROJ + (size_t)m * NATTP;
#define LD4(v, ptr) { const v2u w_ = *(const v2u*)(ptr); v[0] = bf2f(w_.x & 0xffffu); v[1] = bf2f(w_.x >> 16); v[2] = bf2f(w_.y & 0xffffu); v[3] = bf2f(w_.y >> 16); }
#define ROPE_ST4(dst, y, scale) { float o_[4]; _Pragma("unroll") for (int e_ = 0; e_ < 4; ++e_) { const float pp_ = __shfl_xor(y[e_], 8); o_[e_] = (y[e_] * cs[e_] + pp_ * sn[e_]) * (scale); } \
    v2u w_; w_.x = pk2(o_[0], o_[1]); w_.y = pk2(o_[2], o_[3]); *(v2u*)(dst) = w_; }
        {
            float v[4]; LD4(v, pr + 1024 + hs * 64 + d0)
            const float ss = sum16((v[0] * v[0] + v[1] * v[1]) + (v[2] * v[2] + v[3] * v[3]));
            const float rs = rsqrtf(ss * (1.f / 64.f) + EPS);
            float y[4];
#pragma unroll
            for (int e = 0; e < 4; ++e) y[e] = v[e] * rs * kgl[e];
            ROPE_ST4(Kb + (size_t)m * 256 + hs * 64 + d0, y, 1.f)
            *(v2u*)(Vb + (size_t)m * 256 + hs * 64 + d0) = *(const v2u*)(pr + 1280 + hs * 64 + d0);
        }
        {
            float v[4]; LD4(v, pr + 2048 + d0)
            const float mu = sum16((v[0] + v[1]) + (v[2] + v[3])) * (1.f / 64.f);
            float dv[4];
#pragma unroll
            for (int e = 0; e < 4; ++e) dv[e] = v[e] - mu;
            const float var = sum16((dv[0] * dv[0] + dv[1] * dv[1]) + (dv[2] * dv[2] + dv[3] * dv[3])) * (1.f / 64.f);
            const float rs = rsqrtf(var + EPS);
            float y[4], o[4];
#pragma unroll
            for (int e = 0; e < 4; ++e) y[e] = dv[e] * rs * lg[e] + lb[e];
#pragma unroll
            for (int e = 0; e < 4; ++e) { const float pp = __shfl_xor(y[e], 8); o[e] = y[e] * cs[e] + pp * sn[e]; }
            const int sq = m & (T - 1);
            if (hs == 0) { v2u w; w.x = pk2(o[0], o[1]); w.y = pk2(o[2], o[3]);
                *(v2u*)(KIb + (size_t)(m - sq) * 64 + (sq >> 5) * 2048 + (d0 >> 4) * 512 + (((d0 >> 3) & 1) * 32 + (sq & 31)) * 8 + (d0 & 7)) = w; }
        }
        if (lane < 8) WIb[(size_t)m * 8 + lane] = bf2f(pr[2112 + lane]) * 0.04419417382415922f;
#undef LD4
#undef ROPE_ST4
    }
}

__device__ __forceinline__ void conv_phase(const float* cw, const bf16* Zb, bf16* Gb, int tid_in) {
    int tid = tid_in; asm volatile("" : "+v"(tid));
    const int lane = tid & 63, gw = blockIdx.x * NWAVES + __builtin_amdgcn_readfirstlane(tid >> 6), ngw = gridDim.x * NWAVES;
    const bf16* Bgp = Zb + (size_t)M * D;
    const int run = (M + ngw - 1) / ngw;
    const int m0 = gw * run, m1 = (m0 + run < M) ? m0 + run : M;
#define UNPK8(dst, w_) { dst[0] = bf2f(w_.x & 0xffffu); dst[1] = bf2f(w_.x >> 16); dst[2] = bf2f(w_.y & 0xffffu); dst[3] = bf2f(w_.y >> 16); dst[4] = bf2f(w_.z & 0xffffu); dst[5] = bf2f(w_.z >> 16); dst[6] = bf2f(w_.w & 0xffffu); dst[7] = bf2f(w_.w >> 16); }
#pragma unroll
    for (int jp = 0; jp < 2; ++jp) {
        if (m0 >= M) break;
        const int col = 8 * lane + 512 * jp;
        float w0[8], w1[8], w2[8];
        { const f32x4 a0 = *(const f32x4*)(cw + col), a1 = *(const f32x4*)(cw + col + 4), b0 = *(const f32x4*)(cw + 1024 + col), b1 = *(const f32x4*)(cw + 1024 + col + 4), c0 = *(const f32x4*)(cw + 2048 + col), c1 = *(const f32x4*)(cw + 2048 + col + 4);
#pragma unroll
          for (int e = 0; e < 4; ++e) { w0[e] = a0[e]; w0[4 + e] = a1[e]; w1[e] = b0[e]; w1[4 + e] = b1[e]; w2[e] = c0[e]; w2[4 + e] = c1[e]; } }
        float z1[8], z2[8];
        { const int t0 = m0 & (T - 1); const v4u zero = {0u, 0u, 0u, 0u};
          const v4u r1 = (t0 >= 1) ? *(const v4u*)(Zb + (size_t)(m0 - 1) * D + col) : zero, r2 = (t0 >= 2) ? *(const v4u*)(Zb + (size_t)(m0 - 2) * D + col) : zero;
          UNPK8(z1, r1) UNPK8(z2, r2) }
#pragma unroll 4
        for (int m = m0; m < m1; ++m) {
            if ((m & (T - 1)) == 0) {
#pragma unroll
                for (int e = 0; e < 8; ++e) { z1[e] = 0.f; z2[e] = 0.f; } }
            const v4u zr = *(const v4u*)(Zb + (size_t)m * D + col), bb = *(const v4u*)(Bgp + (size_t)m * D + col);
            float z0[8], bv[8], r[8]; UNPK8(z0, zr) UNPK8(bv, bb)
#pragma unroll
            for (int e = 0; e < 8; ++e) { r[e] = (w0[e] * z2[e] + w1[e] * z1[e] + w2[e] * z0[e]) * bv[e]; z2[e] = z1[e]; z1[e] = z0[e]; }
            v4u o; o.x = pk2(r[0], r[1]); o.y = pk2(r[2], r[3]); o.z = pk2(r[4], r[5]); o.w = pk2(r[6], r[7]);
            *(v4u*)(Gb + (size_t)m * D + col) = o;
        }
    }
#undef UNPK8
}


template <int l>
__device__ __forceinline__ void run_layer(const Params& p, LAS unsigned char* lds, const XcdBarrier& bar) {
    const int G = gridDim.x;
    unsigned char* ws = p.ws;
    bf16* Watt = (bf16*)(ws + WS_WATT); bf16* Wao = (bf16*)(ws + WS_WAO); bf16* Wci = (bf16*)(ws + WS_WCI); bf16* Wco = (bf16*)(ws + WS_WCO);
    float* modv = (float*)(ws + WS_MOD);
    bf16* H = (bf16*)(ws + WS_H); bf16* R1 = (bf16*)(ws + WS_R1);
    bf16* Qb = (bf16*)(ws + WS_Q); bf16* QIb = (bf16*)(ws + WS_QI); bf16* Kb = (bf16*)(ws + WS_K); bf16* Vb = (bf16*)(ws + WS_V); bf16* KIb = (bf16*)(ws + WS_KI);
    float* WIb = (float*)(ws + WS_WI); unsigned short* SELb = (unsigned short*)(ws + WS_SEL);
        const float* modl = modv + (size_t)l * 4 * 6144;
        bf16* XR = (bf16*)(ws + WS_XR);
        if (l == 0) norm_rows<false>(p.x, H, p.n1g, modl, 0, threadIdx.x); else norm_rows<true>(XR, H, p.n1g + 1024, modl, 0, threadIdx.x);
#ifdef PROBE_SYNC10
        for (int r_ = 0; r_ < 5; ++r_) xcd_barrier(bar);
#endif
        xcd_barrier(bar);
        { const int N = l == 0 ? NATTP : NCI;
          pg8::Gemm g{H, l == 0 ? Watt : Wci, M, N, 1024}; pg8::StaticOrder S; S.init(M, N, G, (int)blockIdx.x);
          if (l == 0) { EpiAttnIn E{R1, N, ws}; pg8::gemm_phase<EpiAttnIn, pg8::StaticOrder, true, true>(lds, g, S, E); }
          else { EpiConvIn E{R1, R1 + (size_t)M * D}; pg8::gemm_phase<EpiConvIn, pg8::StaticOrder, true, true>(lds, g, S, E); } }
        xcd_barrier(bar);
        if (l == 0) {
#ifndef NO_ATTN
            select_phase(p, lds, R1, KIb, WIb, SELb, threadIdx.x);
#ifdef PROBE_SEL2
            select_phase(p, lds, R1, KIb, WIb, SELb, threadIdx.x);
#endif
            xcd_barrier(bar);
            gather_attn_phase(p, lds, R1, Kb, Vb, SELb, Qb  , threadIdx.x);
#else
            for (size_t i = (size_t)blockIdx.x * NTHR + tid; i < (size_t)M * D / 8; i += (size_t)G * NTHR) ((v4u*)R1)[i] = (v4u){0u, 0u, 0u, 0u};
#endif
        } else {
            conv_phase(p.conv_w, R1, Qb  , threadIdx.x);
#ifdef PROBE_MISC2
            conv_phase(p.conv_w, R1, Qb, threadIdx.x);
#endif
        }
        xcd_barrier(bar);
        { pg8::Gemm g{Qb, l == 0 ? Wao : Wco, M, 1024, 1024}; pg8::StaticOrder S; S.init(M, 1024, G, (int)blockIdx.x);
          if (l == 0) { EpiResid<false, true> E{p.x, XR, modl + 2 * 1024}; pg8::gemm_phase<EpiResid<false, true>, pg8::StaticOrder, true, true>(lds, g, S, E); }
          else { EpiResid<true, true> E{XR, XR, modl + 2 * 1024}; pg8::gemm_phase<EpiResid<true, true>, pg8::StaticOrder, true, true>(lds, g, S, E); } }
        xcd_barrier(bar);
        norm_rows<true>(XR, H, p.n2g + l * 1024, modl, 3, threadIdx.x);
        xcd_barrier(bar);
        { pg8::Gemm g{H, (const bf16*)(ws + (l ? WS_WGU1 : WS_WGU0)), M, NGU, 1024}; pg8::StaticOrder S; S.init(M, NGU, G, (int)blockIdx.x);
          EpiSwiglu E{R1};
          pg8::gemm_phase<EpiSwiglu, pg8::StaticOrder, true, true>(lds, g, S, E);
#ifdef PROBE_GU2
          if (l == 0) pg8::gemm_phase<EpiSwiglu, pg8::StaticOrder, true, true>(lds, g, S, E);
#endif
          }
        xcd_barrier(bar);
        { pg8::Gemm g{R1, (const bf16*)(ws + (l ? WS_WD1 : WS_WD0)), M, 1024, FF}; pg8::StaticOrder S; S.init(M, 1024, G, (int)blockIdx.x);
          if (l == 0) { EpiResid<true, true> E{XR, XR, modl + 5 * 1024}; pg8::gemm_phase<EpiResid<true, true>, pg8::StaticOrder, true, true>(lds, g, S, E); }
          else { EpiResid<true, false> E{XR, p.out, modl + 5 * 1024}; pg8::gemm_phase<EpiResid<true, false>, pg8::StaticOrder, true, true>(lds, g, S, E); } }
        if (l == 0) xcd_barrier(bar);
}

__global__ void __launch_bounds__(NTHR, 2) fwd_kernel(Params p) {
    extern __shared__ __attribute__((aligned(16))) unsigned char lds_raw[];
    cg::grid_group grid = cg::this_grid();
    LAS unsigned char* lds = (LAS unsigned char*)lds_raw;
    const int tid = threadIdx.x, lane = tid & 63, wave = __builtin_amdgcn_readfirstlane(tid >> 6);
    const int G = gridDim.x, gw = blockIdx.x * NWAVES + wave, ngw = G * NWAVES;
    unsigned char* ws = p.ws;
    bf16* Watt = (bf16*)(ws + WS_WATT); bf16* Wao = (bf16*)(ws + WS_WAO); bf16* Wci = (bf16*)(ws + WS_WCI); bf16* Wco = (bf16*)(ws + WS_WCO);
    float* modv = (float*)(ws + WS_MOD);
    bf16* H = (bf16*)(ws + WS_H); bf16* R1 = (bf16*)(ws + WS_R1);
    bf16* Qb = (bf16*)(ws + WS_Q); bf16* QIb = (bf16*)(ws + WS_QI); bf16* Kb = (bf16*)(ws + WS_K); bf16* Vb = (bf16*)(ws + WS_V); bf16* KIb = (bf16*)(ws + WS_KI);
    float* WIb = (float*)(ws + WS_WI);

    if (tid < 4) ((LAS unsigned*)(lds + LDS_BARST))[tid] = 0u;
    __syncthreads();
    const XcdBarrier bar = xcd_barrier_post((unsigned*)(ws + WS_BAR), (volatile LAS unsigned*)(lds + LDS_BARST));
    if (blockIdx.x == 0 && tid < 32) ((float*)(ws + WS_INVF))[tid] = p.inv_freq[tid];
    if (blockIdx.x == 0 && tid == 32) { unsigned long long* pt = (unsigned long long*)(ws + WS_INVF + 256);
        pt[0] = (unsigned long long)p.pos; pt[1] = (unsigned long long)p.kg; pt[2] = (unsigned long long)p.lng; pt[3] = (unsigned long long)p.lnb; pt[4] = (unsigned long long)p.qg; }
#ifdef PROBE_P02
    for (int rep_ = 0; rep_ < 2; ++rep_) {
#else
    {
#endif
    if (blockIdx.x < 192) {
        const int l = blockIdx.x / 96, j0 = (blockIdx.x % 96) * 64;
        LAS float* cact = (LAS float*)(lds + 69632); LAS float* red = (LAS float*)(lds + 86016);
        for (int i = tid; i < 4096; i += NTHR) { const float cv = p.c[i]; cact[i] = cv / (1.f + __expf(-cv)); }
        __syncthreads();
        const int col = tid & 63, ks = tid >> 6;
        float a0 = 0.f, a1 = 0.f, a2 = 0.f, a3 = 0.f;
        const float* wp = p.ada_w + ((size_t)l * 1024 + ks * 128) * 6144 + j0 + col;
#pragma unroll 16
        for (int k = 0; k < 128; ++k) { const float w = wp[(size_t)k * 6144]; const int kk = ks * 128 + k;
            a0 += cact[kk] * w; a1 += cact[1024 + kk] * w; a2 += cact[2048 + kk] * w; a3 += cact[3072 + kk] * w; }
        red[(ks * 64 + col) * 4 + 0] = a0; red[(ks * 64 + col) * 4 + 1] = a1; red[(ks * 64 + col) * 4 + 2] = a2; red[(ks * 64 + col) * 4 + 3] = a3;
        __syncthreads();
        if (tid < 256) { const int c2 = tid & 63, b = tid >> 6; float s = p.ada_b[l * 6144 + j0 + c2];
#pragma unroll
            for (int k2 = 0; k2 < 8; ++k2) s += red[(k2 * 64 + c2) * 4 + b];
            modv[(size_t)(l * 4 + b) * 6144 + j0 + c2] = s; }
    }
    {
        LAS float* scr = (LAS float*)(lds + wave * 8448);
        constexpr int I_ATT = 16 * 72, I_AO = 16 * 32, I_G = 16 * 88, I_D = 44 * 32, I_CI = 16 * 96, I_CO = 16 * 32;
        constexpr int NITEMS = I_ATT + I_AO + 4 * I_G + 2 * I_D + I_CI + I_CO;
        for (int it = gw; it < NITEMS; it += ngw) {
            int r = it;
            if (r < I_ATT) { transpose_item(p.attn_w_in, 1024, NATT, 72, Watt, 4, scr, r, lane); continue; } r -= I_ATT;
            if (r < I_AO) { transpose_item(p.attn_w_out, 1024, 1024, 32, Wao, 0, scr, r, lane); continue; } r -= I_AO;
            if (r < 4 * I_G) { const int which = r / I_G, l = which >> 1, up = which & 1; r -= which * I_G;
                transpose_item((up ? p.wu : p.wg) + (size_t)l * 1024 * FF, 1024, FF, 88, (bf16*)(ws + (l ? WS_WGU1 : WS_WGU0)), 1 + up, scr, r, lane); continue; } r -= 4 * I_G;
            if (r < 2 * I_D) { const int l = r / I_D; r -= l * I_D;
                transpose_item(p.wd + (size_t)l * FF * 1024, FF, 1024, 32, (bf16*)(ws + (l ? WS_WD1 : WS_WD0)), 0, scr, r, lane); continue; } r -= 2 * I_D;
            if (r < I_CI) { transpose_item(p.conv_w_in, 1024, NCI, 96, Wci, 3, scr, r, lane); continue; } r -= I_CI;
            transpose_item(p.conv_w_out, 1024, 1024, 32, Wco, 0, scr, r, lane);
        }
    }
    }
    xcd_barrier(bar);

    run_layer<0>(p, lds, bar);
    run_layer<1>(p, lds, bar);
    if (p.ws == nullptr) grid.sync();
}

extern "C" void kernel_launch(void* const* d_in, const int* in_sizes, int n_in, void* d_out, int out_size, void* d_ws, size_t ws_size, hipStream_t stream) {
    static int grid = 0;
    if (grid == 0) {
        if (n_in != 19 || in_sizes[0] != M * D || out_size != M * D || ws_size < WS_END) { fprintf(stderr, "kernel_launch: unexpected shapes (n_in %d, in0 %d, out %d, ws %zu)\n", n_in, n_in > 0 ? in_sizes[0] : -1, out_size, ws_size); grid = -1; return; }
        int dev = 0, cus = 0, per_cu = 0;
        (void)hipGetDevice(&dev); (void)hipDeviceGetAttribute(&cus, hipDeviceAttributeMultiprocessorCount, dev);
        if (hipFuncSetAttribute((const void*)fwd_kernel, hipFuncAttributeMaxDynamicSharedMemorySize, LDS_BYTES) != hipSuccess) { fprintf(stderr, "kernel_launch: hipFuncSetAttribute failed\n"); grid = -1; return; }
        if (hipOccupancyMaxActiveBlocksPerMultiprocessor(&per_cu, (const void*)fwd_kernel, NTHR, LDS_BYTES) != hipSuccess || per_cu < 1) per_cu = 1;
        (void)hipGetLastError();
        grid = cus * per_cu;
        if (grid <= 0) grid = 256;
    }
    if (grid < 0) return;
    Params p{};
    p.x = (const float*)d_in[0]; p.c = (const float*)d_in[1]; p.pos = (const int*)d_in[2];
    p.ada_w = (const float*)d_in[3]; p.ada_b = (const float*)d_in[4]; p.n1g = (const float*)d_in[5]; p.n2g = (const float*)d_in[6];
    p.attn_w_in = (const float*)d_in[7]; p.qg = (const float*)d_in[8]; p.kg = (const float*)d_in[9]; p.lng = (const float*)d_in[10]; p.lnb = (const float*)d_in[11];
    p.attn_w_out = (const float*)d_in[12]; p.conv_w_in = (const float*)d_in[13]; p.conv_w = (const float*)d_in[14]; p.conv_w_out = (const float*)d_in[15];
    p.wg = (const float*)d_in[16]; p.wu = (const float*)d_in[17]; p.wd = (const float*)d_in[18];
    p.out = (float*)d_out; p.ws = (unsigned char*)d_ws;
    for (int i = 0; i < 32; ++i) p.inv_freq[i] = (float)pow(10000.0, -(double)i / 32.0);
    (void)hipMemsetAsync((unsigned char*)d_ws + WS_BAR, 0, 16384, stream);
    void* args[] = {&p};
    const hipError_t e = hipLaunchCooperativeKernel((const void*)fwd_kernel, dim3(grid), dim3(NTHR), args, LDS_BYTES, stream);
    if (e != hipSuccess) fprintf(stderr, "kernel_launch: cooperative launch failed: %s (grid %d)\n", hipGetErrorString(e), grid);
}
```

```cpp
#include <hip/hip_runtime.h>
#include <hip/hip_cooperative_groups.h>
#include <cstdio>
#include <cstdint>
#include <cmath>
namespace cg = cooperative_groups;
namespace pg8 {
#define PG8_LAS __attribute__((address_space(3)))
typedef unsigned short bf16_t;
typedef short bf16x8 __attribute__((ext_vector_type(8)));
typedef float f32x4 __attribute__((ext_vector_type(4)));
typedef unsigned u32x4 __attribute__((ext_vector_type(4)));
constexpr int BM = 256, BK = 64, HALF = 128, HTB = HALF * BK * 2  , STAGE_BYTES = 8 * HTB, NXCD = 8, WGM = 8;

__host__ __device__ __forceinline__ int lds_byte(int r, int c) { const int st = (r >> 4) * 2 + (c >> 5), rr = r & 15, cc = c & 31, ob = rr * 64 + cc * 2; return st * 1024 + (ob ^ (((ob >> 9) & 1) << 5)); }
__host__ __device__ __forceinline__ void stage_rc(int b, int& R, int& C) { const int st = b / 1024, sb = b % 1024, swz = sb ^ (((sb >> 9) & 1) << 5); R = (st >> 1) * 16 + swz / 64; C = (st & 1) * 32 + (swz % 64) / 2; }
__host__ __device__ __forceinline__ int perm32(int rho) { const int n = rho >> 4, i = rho & 15; return 8 * (i >> 2) + 4 * n + (i & 3); }

struct Unit { int pm, pn; };
struct Gemm { const bf16_t* A; const bf16_t* Bt; int M, N, K; };

struct StaticOrder {
    int nM, nN, nwg, G, c;
    __host__ __device__ void init(int M, int N, int G_, int c_) { nM = M / BM; nN = N / BM; nwg = nM * nN; G = G_; c = c_; }
    __host__ __device__ bool next(int i, Unit& u) const {
        const long L = (long)i * G + c; if (L >= nwg) return false;
        int wgid = (int)L; { const int q = nwg / NXCD, r = nwg % NXCD, xcd = wgid % NXCD, off = wgid / NXCD; wgid = (xcd < r ? xcd * (q + 1) : r * (q + 1) + (xcd - r) * q) + off; }
        const int nig = WGM * nN, gid = wgid / nig, fm = gid * WGM, gsz = (nM - fm) < WGM ? (nM - fm) : WGM;
        u.pm = fm + ((wgid % nig) % gsz); u.pn = (wgid % nig) / gsz; return true;
    }
    __device__ __forceinline__ void a_ready(const Unit&) const {}
    __device__ __forceinline__ void done(const Unit&) const {}
};

__device__ __forceinline__ unsigned cvt_pk_bf16(float lo, float hi) { unsigned r; asm volatile("v_cvt_pk_bf16_f32 %0, %1, %2" : "=v"(r) : "v"(lo), "v"(hi)); return r; }

template <class Epi, class Sched, bool ALIGN_EPI = false, bool SP2 = false>
__device__ __forceinline__ void gemm_phase(PG8_LAS unsigned char* lds, const Gemm g, const Sched& S, const Epi& E) {
    const int tid = threadIdx.x, wid = __builtin_amdgcn_readfirstlane(tid >> 6), lane = tid & 63, wr = wid >> 2, wc = wid & 3, fr = lane & 15, fq = lane >> 4;
    const int K = g.K, nt = K / BK;
    unsigned voffA[2], voffB[2];
#pragma unroll
    for (int i = 0; i < 2; ++i) { int R, C; stage_rc(tid * 16 + i * 8192, R, C); const int Rb = Epi::PERM ? ((R & ~31) + perm32(R & 31)) : R;
        voffA[i] = (unsigned)(R * K + C) * 2u; voffB[i] = (unsigned)(Rb * K + C) * 2u; }
    const size_t kstep = (size_t)(BK * 2);
    const size_t hstep = (size_t)HALF * K * 2;
    const size_t tstep = 2 * hstep;
    const unsigned ldsw = (unsigned)wid * 1024u;
    const int aoff = lds_byte(wr * 64 + fr, fq * 8), boff = lds_byte(wc * 32 + fr, fq * 8);
#define PG8_SA(b, h) (((b) * 2 + (h)) * HTB)
#define PG8_SB(b, h) ((4 + (b) * 2 + (h)) * HTB)
#define PG8_STAGE(bufoff, gbase, voff) do { _Pragma("unroll") for (int _i = 0; _i < 2; ++_i) \
        __builtin_amdgcn_global_load_lds((const unsigned*)((const char*)(gbase) + (voff)[_i]), (PG8_LAS unsigned*)(lds + (bufoff) + ldsw + _i * 8192), 16, 0, 0); } while (0)
#define PG8_LDA(dst, b, h) do { _Pragma("unroll") for (int m = 0; m < 4; ++m) _Pragma("unroll") for (int k = 0; k < 2; ++k) dst[m][k] = *(const PG8_LAS bf16x8*)(lds + PG8_SA(b, h) + aoff + m * 2048 + k * 1024); } while (0)
#define PG8_LDB(dst, b, h) do { _Pragma("unroll") for (int n = 0; n < 2; ++n) _Pragma("unroll") for (int k = 0; k < 2; ++k) dst[n][k] = *(const PG8_LAS bf16x8*)(lds + PG8_SB(b, h) + boff + n * 2048 + k * 1024); } while (0)
#define PG8_MMA(ai, bj, At, Bt) do { __builtin_amdgcn_s_setprio(1); _Pragma("unroll") for (int m = 0; m < 4; ++m) _Pragma("unroll") for (int n = 0; n < 2; ++n) _Pragma("unroll") for (int k = 0; k < 2; ++k) \
        acc[ai][bj][m][n] = __builtin_amdgcn_mfma_f32_16x16x32_bf16(Bt[n][k], At[m][k], acc[ai][bj][m][n], 0, 0, 0); __builtin_amdgcn_s_setprio(0); } while (0)
#define PG8_WAIT_V(n) asm volatile("s_waitcnt vmcnt(" #n ")" ::: "memory")
#define PG8_WAIT_L(n) asm volatile("s_waitcnt lgkmcnt(" #n ")" ::: "memory")
#define PG8_BAR __builtin_amdgcn_s_barrier()
#define PG8_SCHED __builtin_amdgcn_sched_barrier(0)
    Unit cur, nxt; int ui = 0;
    if (!S.next(0, cur)) return;
    f32x4 acc[2][2][4][2];
#pragma unroll
    for (int a = 0; a < 2; ++a)
#pragma unroll
        for (int b = 0; b < 2; ++b)
#pragma unroll
            for (int m = 0; m < 4; ++m)
#pragma unroll
                for (int n = 0; n < 2; ++n) acc[a][b][m][n] = (f32x4){0.f, 0.f, 0.f, 0.f};
    bf16x8 At[4][2], B0[2][2], B1[2][2];
    const char* cA = (const char*)g.A + (size_t)cur.pm * tstep; const char* cB = (const char*)g.Bt + (size_t)cur.pn * tstep;
    S.a_ready(cur);
    if constexpr (SP2) {
        PG8_STAGE(PG8_SB(0, 0), cB, voffB); PG8_STAGE(PG8_SB(0, 1), cB + hstep, voffB); PG8_STAGE(PG8_SA(0, 0), cA, voffA); PG8_STAGE(PG8_SA(0, 1), cA + hstep, voffA);
        if (wr == 1) PG8_BAR;
        PG8_WAIT_V(2); PG8_BAR;
        PG8_STAGE(PG8_SB(1, 0), cB + kstep, voffB); PG8_STAGE(PG8_SA(1, 0), cA + kstep, voffA); PG8_STAGE(PG8_SB(1, 1), cB + hstep + kstep, voffB);
        PG8_WAIT_V(6); PG8_BAR;
    } else {
        PG8_STAGE(PG8_SB(0, 0), cB, voffB); PG8_STAGE(PG8_SA(0, 0), cA, voffA); PG8_STAGE(PG8_SB(0, 1), cB + hstep, voffB); PG8_STAGE(PG8_SA(0, 1), cA + hstep, voffA);
        if (wr == 1) PG8_BAR;
        PG8_WAIT_V(4); PG8_BAR;
        PG8_STAGE(PG8_SB(1, 0), cB + kstep, voffB); PG8_STAGE(PG8_SA(1, 0), cA + kstep, voffA); PG8_STAGE(PG8_SB(1, 1), cB + hstep + kstep, voffB);
        PG8_WAIT_V(6); PG8_BAR;
    }
    for (;;) {
        const bool has_next = S.next(ui + 1, nxt);
        const char* nA = has_next ? (const char*)g.A + (size_t)nxt.pm * tstep : cA; const char* nB = has_next ? (const char*)g.Bt + (size_t)nxt.pn * tstep : cB;
        for (int t = 0; t < nt; t += 2) {
            const bool last = (t == nt - 2);
            const char* a1 = cA + (size_t)(t + 1) * kstep;
            const char* a2 = last ? nA : cA + (size_t)(t + 2) * kstep; const char* b2 = last ? nB : cB + (size_t)(t + 2) * kstep;
            const char* a3 = a2 + kstep; const char* b3 = b2 + kstep;
            if (last && has_next) S.a_ready(nxt);
            if constexpr (SP2) {
            PG8_LDB(B0, 0, 0); PG8_LDB(B1, 0, 1); PG8_SCHED; PG8_LDA(At, 0, 0); PG8_STAGE(PG8_SA(1, 1), a1 + hstep, voffA);
            PG8_WAIT_V(8); PG8_WAIT_L(0); PG8_BAR; PG8_MMA(0, 0, At, B0); PG8_MMA(0, 1, At, B1); PG8_BAR; PG8_SCHED;
            PG8_LDA(At, 0, 1); PG8_STAGE(PG8_SB(0, 0), b2, voffB); PG8_STAGE(PG8_SB(0, 1), b2 + hstep, voffB); PG8_STAGE(PG8_SA(0, 0), a2, voffA);
            PG8_WAIT_V(8); PG8_WAIT_L(0); PG8_BAR; PG8_MMA(1, 0, At, B0); PG8_MMA(1, 1, At, B1); PG8_BAR; PG8_SCHED;
            PG8_LDB(B0, 1, 0); PG8_LDB(B1, 1, 1); PG8_SCHED; PG8_LDA(At, 1, 0); PG8_STAGE(PG8_SA(0, 1), a2 + hstep, voffA);
            PG8_WAIT_V(8); PG8_WAIT_L(0); PG8_BAR; PG8_MMA(0, 0, At, B0); PG8_MMA(0, 1, At, B1); PG8_BAR; PG8_SCHED;
            PG8_LDA(At, 1, 1); PG8_STAGE(PG8_SB(1, 0), b3, voffB); PG8_STAGE(PG8_SB(1, 1), b3 + hstep, voffB); PG8_STAGE(PG8_SA(1, 0), a3, voffA);
            PG8_WAIT_V(8); PG8_WAIT_L(0); PG8_BAR; PG8_MMA(1, 0, At, B0); PG8_MMA(1, 1, At, B1); PG8_BAR; PG8_SCHED;
            } else {
            PG8_LDB(B0, 0, 0); PG8_SCHED; PG8_LDA(At, 0, 0); PG8_STAGE(PG8_SA(1, 1), a1 + hstep, voffA);
            PG8_WAIT_L(8); PG8_BAR; PG8_WAIT_L(0); PG8_MMA(0, 0, At, B0); PG8_BAR; PG8_SCHED;
            PG8_LDB(B1, 0, 1); PG8_STAGE(PG8_SB(0, 0), b2, voffB);
            PG8_BAR; PG8_WAIT_L(0); PG8_MMA(0, 1, At, B1); PG8_BAR;
            PG8_LDA(At, 0, 1); PG8_STAGE(PG8_SA(0, 0), a2, voffA);
            PG8_BAR; PG8_WAIT_L(0); PG8_MMA(1, 0, At, B0); PG8_BAR; PG8_SCHED;
            PG8_STAGE(PG8_SB(0, 1), b2 + hstep, voffB);
            PG8_WAIT_V(6); PG8_BAR; PG8_MMA(1, 1, At, B1); PG8_BAR;
            PG8_LDB(B0, 1, 0); PG8_SCHED; PG8_LDA(At, 1, 0); PG8_STAGE(PG8_SA(0, 1), a2 + hstep, voffA);
            PG8_WAIT_L(8); PG8_BAR; PG8_WAIT_L(0); PG8_MMA(0, 0, At, B0); PG8_BAR; PG8_SCHED;
            PG8_LDB(B1, 1, 1); PG8_STAGE(PG8_SB(1, 0), b3, voffB);
            PG8_BAR; PG8_WAIT_L(0); PG8_MMA(0, 1, At, B1); PG8_BAR;
            PG8_LDA(At, 1, 1); PG8_STAGE(PG8_SA(1, 0), a3, voffA);
            PG8_BAR; PG8_WAIT_L(0); PG8_MMA(1, 0, At, B0); PG8_BAR; PG8_SCHED;
            PG8_STAGE(PG8_SB(1, 1), b3 + hstep, voffB);
            PG8_WAIT_V(6); PG8_BAR; PG8_MMA(1, 1, At, B1); PG8_BAR;
            }
        }
        if constexpr (ALIGN_EPI) { if (wr == 0) PG8_BAR; }
        if constexpr (!Epi::AFTER_DRAIN) { E(acc, cur, wr, wc, fr, fq); S.done(cur); }
        if (!has_next) break;
#pragma unroll
        for (int a = 0; a < 2; ++a)
#pragma unroll
            for (int b = 0; b < 2; ++b)
#pragma unroll
                for (int m = 0; m < 4; ++m)
#pragma unroll
                    for (int n = 0; n < 2; ++n) acc[a][b][m][n] = (f32x4){0.f, 0.f, 0.f, 0.f};
        cur = nxt; cA = nA; cB = nB; ++ui;
        if constexpr (ALIGN_EPI) { if (wr == 1) PG8_BAR; }
    }
    PG8_WAIT_V(0);
    if constexpr (!ALIGN_EPI) { if (wr == 0) PG8_BAR; }
    PG8_BAR;
    if constexpr (Epi::AFTER_DRAIN) { E.fused(acc, cur, wr, wc, fr, fq, lds, wid, lane); S.done(cur); }
#undef PG8_SA
#undef PG8_SB
#undef PG8_STAGE
#undef PG8_LDA
#undef PG8_LDB
#undef PG8_MMA
#undef PG8_WAIT_V
#undef PG8_WAIT_L
#undef PG8_BAR
#undef PG8_SCHED
}
}

constexpr int NBATCH = 4, T = 8192, D = 1024, M = NBATCH * T;
constexpr int FF = 2816, NGU = 2 * FF;
constexpr int NATT = 2120, NATTP = 2304, NCI = 3072;
constexpr float EPS = 1e-6f;
constexpr int NWAVES = 8, NTHR = 512;
constexpr int LDS_BYTES = 155648, LDS_BARST = 155136;

#define GAS __attribute__((address_space(1)))
#define LAS __attribute__((address_space(3)))
typedef unsigned short bf16;
typedef unsigned v4u __attribute__((ext_vector_type(4)));
typedef unsigned v2u __attribute__((ext_vector_type(2)));
typedef float f32x4 __attribute__((ext_vector_type(4)));
typedef float f32x16 __attribute__((ext_vector_type(16)));
typedef short bf16x8 __attribute__((ext_vector_type(8)));
#define LDS_WAIT() asm volatile("s_waitcnt lgkmcnt(0)" ::: "memory")

constexpr size_t MiB = 1u << 20;
constexpr size_t WS_WATT = 0, WS_WAO = 5 * MiB, WS_WGU0 = 7 * MiB, WS_WGU1 = 18 * MiB, WS_WD0 = 29 * MiB, WS_WD1 = 35 * MiB,
                 WS_WCI = 41 * MiB, WS_WCO = 47 * MiB, WS_MOD = 49 * MiB, WS_INVF = 50 * MiB, WS_H = 64 * MiB, WS_R1 = 128 * MiB,
                 WS_Q = 320 * MiB, WS_QI = 384 * MiB, WS_K = 416 * MiB, WS_V = 432 * MiB,
                 WS_KI = 272 * MiB, WS_WI = 276 * MiB, WS_SEL = 277 * MiB  , WS_BAR = 60 * MiB, WS_XR = 448 * MiB  , WS_END = 512 * MiB;

#define XB_TMO      128
#define XB_XCNT(j)  (256  + 64 * (j))
#define XB_XSUB(j)  (1280 + 64 * (j))
#define XB_XGEN(j)  (2304 + 64 * (j))
#define XB_TOP      3328
#define XB_TOPGEN   3392
#define XCD_BAR_WORDS 3456
#define XB_SPIN_CAP (1u << 18)

__device__ __forceinline__ unsigned xb_ld(unsigned* p)              { return __hip_atomic_load(p, __ATOMIC_RELAXED, __HIP_MEMORY_SCOPE_AGENT); }
__device__ __forceinline__ unsigned xb_add(unsigned* p, unsigned v) { return __hip_atomic_fetch_add(p, v, __ATOMIC_RELAXED, __HIP_MEMORY_SCOPE_AGENT); }
__device__ __forceinline__ unsigned xb_xcc_id() { return (unsigned)__builtin_amdgcn_s_getreg((3 << 11) | 20) & 0xFu; }
#define XB_SPIN(cond, bar) do { unsigned _sp = 0; while (cond) { __builtin_amdgcn_s_sleep(1); \
    if ((++_sp & 255u) == 0u) { if (xb_ld(&(bar)[XB_TMO])) break; if (_sp > XB_SPIN_CAP) { atomicAdd(&(bar)[XB_TMO], 1u); break; } } } } while (0)

struct XcdBarrier {
    unsigned* bar; unsigned x;
    volatile LAS unsigned* st;
};

__device__ __forceinline__ XcdBarrier xcd_barrier_post(unsigned* bar, volatile LAS unsigned* st) {
    XcdBarrier b; b.bar = bar; b.x = xb_xcc_id(); b.st = st;
    if (threadIdx.x == 0) (void)xb_add(&bar[XB_XCNT(b.x)], 1u);
    return b;
}
__device__ __forceinline__ void xcd_barrier_complete(unsigned* bar, unsigned x, unsigned& nloc, unsigned& nx) {
    const unsigned G = gridDim.x * gridDim.y * gridDim.z;
    unsigned sum, cnt, mine, sp = 0u;
    for (;;) {
        sum = 0u; cnt = 0u; mine = 0u;
#pragma unroll
        for (unsigned j = 0; j < 16; ++j) { const unsigned c = xb_ld(&bar[XB_XCNT(j)]); sum += c; cnt += (c > 0u) ? 1u : 0u; mine = (j == x) ? c : mine; }
        if (sum == G) break;
        __builtin_amdgcn_s_sleep(1);
        if ((++sp & 255u) == 0u) { if (xb_ld(&bar[XB_TMO])) break; if (sp > XB_SPIN_CAP) { atomicAdd(&bar[XB_TMO], 1u); break; } }
    }
    nloc = mine > 0u ? mine : 1u; nx = cnt > 0u ? cnt : 1u;
}

__device__ __forceinline__ void xcd_barrier(const XcdBarrier& b) {
    asm volatile("s_waitcnt vmcnt(0)" ::: "memory");
    __syncthreads();
    if (threadIdx.x == 0) {
        unsigned* bar = b.bar;
        __builtin_amdgcn_s_waitcnt(0);
        unsigned nloc = b.st[0], nx = b.st[1];
        if (nloc == 0u) { xcd_barrier_complete(bar, b.x, nloc, nx); b.st[0] = nloc; b.st[1] = nx; }
        const unsigned old = xb_add(&bar[XB_XSUB(b.x)], 1u);
        const unsigned gen = old / nloc;
        if (old + 1u == (gen + 1u) * nloc) {
            __builtin_amdgcn_fence(__ATOMIC_RELEASE, "agent");
            asm volatile("s_waitcnt vmcnt(0)" ::: "memory");
            const unsigned og = xb_add(&bar[XB_TOP], 1u);
            const unsigned tg = og / nx;
            if (og + 1u == (tg + 1u) * nx) xb_add(&bar[XB_TOPGEN], 1u);
            else XB_SPIN(xb_ld(&bar[XB_TOPGEN]) == tg, bar);
            __builtin_amdgcn_fence(__ATOMIC_ACQUIRE, "agent");
            xb_add(&bar[XB_XGEN(b.x)], 1u);
            asm volatile("s_waitcnt vmcnt(0)" ::: "memory");
        } else {
            XB_SPIN(xb_ld(&bar[XB_XGEN(b.x)]) == gen, bar);
            __builtin_amdgcn_fence(__ATOMIC_ACQUIRE, "agent");
            asm volatile("s_waitcnt vmcnt(0)" ::: "memory");
        }
    }
    __syncthreads();
}


struct Params {
    const float* x; const float* c; const int* pos;
    const float* ada_w; const float* ada_b; const float* n1g; const float* n2g;
    const float* attn_w_in; const float* qg; const float* kg; const float* lng; const float* lnb; const float* attn_w_out;
    const float* conv_w_in; const float* conv_w; const float* conv_w_out;
    const float* wg; const float* wu; const float* wd;
    float* out; unsigned char* ws;
    float inv_freq[32];
};

__device__ __forceinline__ float bf2f(unsigned v) { return __builtin_bit_cast(float, v << 16); }
__device__ __forceinline__ unsigned f2bf(float f) { unsigned u = __builtin_bit_cast(unsigned, f); return (u + 0x7fffu + ((u >> 16) & 1u)) >> 16; }
__device__ __forceinline__ unsigned pk2(float lo, float hi) { return pg8::cvt_pk_bf16(lo, hi); }
__device__ __forceinline__ float wave_sum(float v) {
#pragma unroll
    for (int o = 1; o < 64; o <<= 1) v += __shfl_xor(v, o);
    return v;
}

__device__ __forceinline__ void sincos_ang(float ang, float& s, float& c);
struct EpiAttnIn {
    static constexpr bool PERM = true, AFTER_DRAIN = false;
    bf16* O; int ldc; unsigned char* ws;
    __device__ __forceinline__ void operator()(const pg8::f32x4 (&acc)[2][2][4][2], const pg8::Unit& u, int wr, int wc, int fr, int fq) const {
        const int row0 = u.pm * 256 + wr * 64 + fr;
        bf16* Kb = (bf16*)(ws + WS_K); bf16* Vb = (bf16*)(ws + WS_V); bf16* KIb = (bf16*)(ws + WS_KI); float* WIb = (float*)(ws + WS_WI);
        const float* invf = (const float*)(ws + WS_INVF);
        if (u.pn == 5) {
#pragma unroll
            for (int ai = 0; ai < 2; ++ai)
#pragma unroll
                for (int m = 0; m < 4; ++m) { bf16* rowp = Vb + (size_t)(row0 + ai * 128 + m * 16) * 256 + wc * 64 + 8 * fq;
#pragma unroll
                    for (int bj = 0; bj < 2; ++bj) { const pg8::f32x4 v0 = acc[ai][bj][m][0], v1 = acc[ai][bj][m][1];
                        v4u w; w.x = pk2(v0[0], v0[1]); w.y = pk2(v0[2], v0[3]); w.z = pk2(v1[0], v1[1]); w.w = pk2(v1[2], v1[3]);
                        *(v4u*)(rowp + bj * 32) = w; } }
            return;
        }
        if (u.pn == 8 && wc >= 2) return;
        if (u.pn == 8 && wc == 1) {
            if (fq == 0) {
#pragma unroll
                for (int ai = 0; ai < 2; ++ai)
#pragma unroll
                    for (int m = 0; m < 4; ++m) { float* wp = WIb + (size_t)(row0 + ai * 128 + m * 16) * 8;
                        *(f32x4*)wp = acc[ai][0][m][0] * 0.04419417382415922f; *(f32x4*)(wp + 4) = acc[ai][0][m][1] * 0.04419417382415922f; }
            }
            return;
        }
        if (u.pn == 6 || u.pn == 7) {
            float fq8[8];
#pragma unroll
            for (int e = 0; e < 8; ++e) fq8[e] = invf[8 * fq + e];
            const int* posq = (const int*)((const unsigned long long*)(ws + WS_INVF + 256))[0];
#pragma unroll
            for (int ai = 0; ai < 2; ++ai)
#pragma unroll
                for (int m = 0; m < 4; ++m) { const int row = row0 + ai * 128 + m * 16; const float posf = (float)posq[row]; float ol[8], oh[8];
#pragma unroll
                    for (int e = 0; e < 8; ++e) { const float xl = bf2f(f2bf(acc[ai][0][m][e >> 2][e & 3])), xh = bf2f(f2bf(acc[ai][1][m][e >> 2][e & 3])); float sn, cs; sincos_ang(posf * fq8[e], sn, cs);
                        ol[e] = xl * cs - xh * sn; oh[e] = xh * cs + xl * sn; }
                    v4u wl, wh; wl.x = pk2(ol[0], ol[1]); wl.y = pk2(ol[2], ol[3]); wl.z = pk2(ol[4], ol[5]); wl.w = pk2(ol[6], ol[7]);
                    wh.x = pk2(oh[0], oh[1]); wh.y = pk2(oh[2], oh[3]); wh.z = pk2(oh[4], oh[5]); wh.w = pk2(oh[6], oh[7]);
                    bf16* qp = O + (size_t)row * ldc + u.pn * 256 + wc * 64 + 8 * fq; *(v4u*)qp = wl; *(v4u*)(qp + 32) = wh; }
            return;
        }
        const bool isk = (u.pn <= 4), isq = (u.pn < 4);
        const unsigned long long* ptab = (const unsigned long long*)(ws + WS_INVF + 256);
        const int* pos = (const int*)ptab[0]; const float* kg = (const float*)ptab[1]; const float* lng = (const float*)ptab[2]; const float* lnb = (const float*)ptab[3]; const float* qg = (const float*)ptab[4];
        float fr8[8];
#pragma unroll
        for (int e = 0; e < 8; ++e) fr8[e] = invf[8 * fq + e];
#pragma unroll
        for (int ai = 0; ai < 2; ++ai)
#pragma unroll
            for (int m = 0; m < 4; ++m) { const int row = row0 + ai * 128 + m * 16;
                float vl[8], vh[8];
#pragma unroll
                for (int e = 0; e < 8; ++e) { vl[e] = acc[ai][0][m][e >> 2][e & 3]; vh[e] = acc[ai][1][m][e >> 2][e & 3]; }
                float mu = 0.f;
                if (!isk) { float sm = 0.f;
#pragma unroll
                    for (int e = 0; e < 8; ++e) sm += vl[e] + vh[e];
                    sm += __shfl_xor(sm, 16); sm += __shfl_xor(sm, 32); mu = sm * (1.f / 64.f); }
                float ss = 0.f;
#pragma unroll
                for (int e = 0; e < 8; ++e) { vl[e] -= mu; vh[e] -= mu; ss += vl[e] * vl[e] + vh[e] * vh[e]; }
                ss += __shfl_xor(ss, 16); ss += __shfl_xor(ss, 32);
                const float rs = rsqrtf(ss * (1.f / 64.f) + EPS) * (isq ? 0.125f * 1.4426950408889634f : 1.f)    , posf = (float)pos[row];
                float ol[8], oh[8];
                const float* lbp = lnb + 8 * fq; const float* gpp = (isq ? qg : (isk ? kg : lng)) + 8 * fq; asm volatile("" : "+v"(lbp), "+v"(gpp));
#pragma unroll
                for (int e = 0; e < 8; ++e) { const float yl = vl[e] * rs * gpp[e] + (isk ? 0.f : lbp[e]), yh = vh[e] * rs * gpp[32 + e] + (isk ? 0.f : lbp[32 + e]); float sn, cs; sincos_ang(posf * fr8[e], sn, cs);
                    ol[e] = yl * cs - yh * sn; oh[e] = yh * cs + yl * sn; }
                v4u wl, wh; wl.x = pk2(ol[0], ol[1]); wl.y = pk2(ol[2], ol[3]); wl.z = pk2(ol[4], ol[5]); wl.w = pk2(ol[6], ol[7]);
                wh.x = pk2(oh[0], oh[1]); wh.y = pk2(oh[2], oh[3]); wh.z = pk2(oh[4], oh[5]); wh.w = pk2(oh[6], oh[7]);
                if (isq) { bf16* qp = O + (size_t)row * ldc + u.pn * 256 + wc * 64 + 8 * fq; *(v4u*)qp = wl; *(v4u*)(qp + 32) = wh; }
                else if (isk) { bf16* kp = Kb + (size_t)row * 256 + wc * 64 + 8 * fq; *(v4u*)kp = wl; *(v4u*)(kp + 32) = wh; }
                else { const int sq = row & (T - 1);
                    bf16* kp = KIb + (size_t)(row - sq) * 64 + (sq >> 5) * 2048 + (sq & 31) * 8;
                    const int dl = 8 * fq, dh = 32 + 8 * fq;
                    *(v4u*)(kp + (dl >> 4) * 512 + ((dl >> 3) & 1) * 256) = wl; *(v4u*)(kp + (dh >> 4) * 512 + ((dh >> 3) & 1) * 256) = wh; }
            }
    }
};
struct EpiStore {
    static constexpr bool PERM = true, AFTER_DRAIN = false;
    bf16* O; int ldc;
    __device__ __forceinline__ void operator()(const pg8::f32x4 (&acc)[2][2][4][2], const pg8::Unit& u, int wr, int wc, int fr, int fq) const {
        const int row0 = u.pm * 256 + wr * 64 + fr, col0 = u.pn * 256 + wc * 32 + 8 * fq;
#pragma unroll
        for (int ai = 0; ai < 2; ++ai)
#pragma unroll
            for (int m = 0; m < 4; ++m) { bf16* rowp = O + (size_t)(row0 + ai * 128 + m * 16) * ldc + col0;
#pragma unroll
                for (int bj = 0; bj < 2; ++bj) { const pg8::f32x4 v0 = acc[ai][bj][m][0], v1 = acc[ai][bj][m][1];
                    v4u w; w.x = pk2(v0[0], v0[1]); w.y = pk2(v0[2], v0[3]); w.z = pk2(v1[0], v1[1]); w.w = pk2(v1[2], v1[3]);
                    *(v4u*)(rowp + bj * 128) = w; } }
    }
};
template <bool XIN_BF16, bool OUT_BF16> struct EpiResid {
    static constexpr bool PERM = true, AFTER_DRAIN = false;
    const void* xin; void* out; const float* gate;
    __device__ __forceinline__ void operator()(const pg8::f32x4 (&acc)[2][2][4][2], const pg8::Unit& u, int wr, int wc, int fr, int fq) const {
        const int row0 = u.pm * 256 + wr * 64 + fr, col0 = u.pn * 256 + wc * 32 + 8 * fq;
        const float* gp = gate + (size_t)((u.pm * 256) >> 13) * 6144 + col0;
        f32x4 gv[2][2];
#pragma unroll
        for (int bj = 0; bj < 2; ++bj)
#pragma unroll
            for (int n = 0; n < 2; ++n) gv[bj][n] = *(const f32x4*)(gp + bj * 128 + 4 * n);
#pragma unroll
        for (int ai = 0; ai < 2; ++ai)
#pragma unroll
            for (int m = 0; m < 4; ++m) { const size_t rb = (size_t)(row0 + ai * 128 + m * 16) * D + col0;
#pragma unroll
                for (int bj = 0; bj < 2; ++bj) { f32x4 x0, x1;
                    if (XIN_BF16) { const v4u w = *(const v4u*)((const bf16*)xin + rb + bj * 128);
                        x0 = (f32x4){bf2f(w.x & 0xffffu), bf2f(w.x >> 16), bf2f(w.y & 0xffffu), bf2f(w.y >> 16)}; x1 = (f32x4){bf2f(w.z & 0xffffu), bf2f(w.z >> 16), bf2f(w.w & 0xffffu), bf2f(w.w >> 16)}; }
                    else { x0 = *(const f32x4*)((const float*)xin + rb + bj * 128); x1 = *(const f32x4*)((const float*)xin + rb + bj * 128 + 4); }
                    const f32x4 o0 = x0 + gv[bj][0] * acc[ai][bj][m][0], o1 = x1 + gv[bj][1] * acc[ai][bj][m][1];
                    if (OUT_BF16) { v4u w; w.x = pk2(o0.x, o0.y); w.y = pk2(o0.z, o0.w); w.z = pk2(o1.x, o1.y); w.w = pk2(o1.z, o1.w); *(v4u*)((bf16*)out + rb + bj * 128) = w; }
                    else { *(f32x4*)((float*)out + rb + bj * 128) = o0; *(f32x4*)((float*)out + rb + bj * 128 + 4) = o1; } } }
    }
};
struct EpiConvIn {
    static constexpr bool PERM = true, AFTER_DRAIN = false;
    bf16* Z; bf16* Bg;
    __device__ __forceinline__ void operator()(const pg8::f32x4 (&acc)[2][2][4][2], const pg8::Unit& u, int wr, int wc, int fr, int fq) const {
        const int row0 = u.pm * 256 + wr * 64 + fr;
        if (u.pn < 8) {
            const int ch0 = u.pn * 128 + wc * 32 + 8 * fq;
#pragma unroll
            for (int ai = 0; ai < 2; ++ai)
#pragma unroll
                for (int m = 0; m < 4; ++m) { bf16* rowp = Z + (size_t)(row0 + ai * 128 + m * 16) * D + ch0;
                    const pg8::f32x4 z0 = acc[ai][0][m][0] * acc[ai][1][m][0], z1 = acc[ai][0][m][1] * acc[ai][1][m][1];
                    v4u w; w.x = pk2(z0[0], z0[1]); w.y = pk2(z0[2], z0[3]); w.z = pk2(z1[0], z1[1]); w.w = pk2(z1[2], z1[3]); *(v4u*)rowp = w; }
        } else {
            const int col0 = (u.pn - 8) * 256 + wc * 32 + 8 * fq;
#pragma unroll
            for (int ai = 0; ai < 2; ++ai)
#pragma unroll
                for (int m = 0; m < 4; ++m) { bf16* rowp = Bg + (size_t)(row0 + ai * 128 + m * 16) * D + col0;
#pragma unroll
                    for (int bj = 0; bj < 2; ++bj) { const pg8::f32x4 v0 = acc[ai][bj][m][0], v1 = acc[ai][bj][m][1];
                        v4u w; w.x = pk2(v0[0], v0[1]); w.y = pk2(v0[2], v0[3]); w.z = pk2(v1[0], v1[1]); w.w = pk2(v1[2], v1[3]);
                        *(v4u*)(rowp + bj * 128) = w; } }
        }
    }
};
struct EpiSwiglu {
    static constexpr bool PERM = true, AFTER_DRAIN = false;
    bf16* ACT;
    __device__ __forceinline__ void operator()(const pg8::f32x4 (&acc)[2][2][4][2], const pg8::Unit& u, int wr, int wc, int fr, int fq) const {
        const int row0 = u.pm * 256 + wr * 64 + fr, hid0 = u.pn * 128 + wc * 32 + 8 * fq;
#pragma unroll
        for (int ai = 0; ai < 2; ++ai)
#pragma unroll
            for (int m = 0; m < 4; ++m) { bf16* rowp = ACT + (size_t)(row0 + ai * 128 + m * 16) * FF + hid0; float r[8];
#pragma unroll
                for (int n = 0; n < 2; ++n) { const pg8::f32x4 g = acc[ai][0][m][n], uu = acc[ai][1][m][n];
#pragma unroll
                    for (int e = 0; e < 4; ++e) r[4 * n + e] = g[e] * __builtin_amdgcn_rcpf(1.f + __expf(-g[e])) * uu[e]; }
                v4u w; w.x = pk2(r[0], r[1]); w.y = pk2(r[2], r[3]); w.z = pk2(r[4], r[5]); w.w = pk2(r[6], r[7]);
                *(v4u*)rowp = w; }
    }
};

__device__ __forceinline__ void transpose_item(const float* W, int K, int N, int nblk, bf16* WT, int mode, LAS float* scr, int item, int lane) {
    const int kb = item / nblk, nb = item % nblk, k0 = 64 * kb, n0 = 32 * nb;
    const int ncol = n0 + (lane & 31);
#pragma unroll
    for (int i = 0; i < 32; ++i) { const int kk = 2 * i + (lane >> 5); scr[kk * 33 + (lane & 31)] = (ncol < N) ? W[(size_t)(k0 + kk) * N + ncol] : 0.f; }
    LDS_WAIT();
    const int c = lane & 7;
#pragma unroll
    for (int j = 0; j < 4; ++j) { const int nl = (lane >> 3) + 8 * j, n = n0 + nl; const LAS float* s = scr + (8 * c) * 33 + nl;
        v4u o; o.x = pk2(s[0 * 33], s[1 * 33]); o.y = pk2(s[2 * 33], s[3 * 33]); o.z = pk2(s[4 * 33], s[5 * 33]); o.w = pk2(s[6 * 33], s[7 * 33]);
        int dest;
        if (mode == 0) dest = n;
        else if (mode == 4) { const int tile = n >> 8, o = n & 255; dest = tile * 256 + 128 * ((o >> 5) & 1) + 32 * (o >> 6) + (o & 31); (void)n; }
        else if (mode == 3) { const int j = n & 1023; dest = (n < 1024) ? 2048 + n : (256 * (j >> 7) + (j & 127) + (n >= 2048 ? 128 : 0)); }
        else dest = 256 * (n >> 7) + (n & 127) + (mode == 2 ? 128 : 0);
        *(v4u*)(WT + (size_t)dest * K + k0 + 8 * c) = o; }
    LDS_WAIT();
}

template <bool IN_BF16>
__device__ __forceinline__ void norm_rows(const void* xin, bf16* H, const float* g, const float* modl, int shift_idx, int tid_in) {
    int tid = tid_in; asm volatile("" : "+v"(tid));
    const int lane = tid & 63, gw = blockIdx.x * NWAVES + __builtin_amdgcn_readfirstlane(tid >> 6), ngw = gridDim.x * NWAVES;
    f32x4 vn[4];
#define NR_LOAD(mrow) { _Pragma("unroll") for (int j_ = 0; j_ < 4; ++j_) { \
        if (IN_BF16) { const v2u w_ = ((const v2u*)((const bf16*)xin + (size_t)(mrow) * D) + lane)[64 * j_]; vn[j_] = (f32x4){bf2f(w_.x & 0xffffu), bf2f(w_.x >> 16), bf2f(w_.y & 0xffffu), bf2f(w_.y >> 16)}; } \
        else vn[j_] = ((const f32x4*)((const float*)xin + (size_t)(mrow) * D) + lane)[64 * j_]; } }
    if (gw < M) NR_LOAD(gw)
    for (int m = gw; m < M; m += ngw) {
        const float* sh = modl + (size_t)(m >> 13) * 6144 + shift_idx * 1024; const float* sc = sh + 1024;
        f32x4 v[4]; float ss = 0.f;
#pragma unroll
        for (int j = 0; j < 4; ++j) { v[j] = vn[j]; ss += (v[j].x * v[j].x + v[j].y * v[j].y) + (v[j].z * v[j].z + v[j].w * v[j].w); }
        { const int mn = (m + ngw < M) ? m + ngw : m; NR_LOAD(mn) }
        const float rstd = rsqrtf(wave_sum(ss) * (1.f / D) + EPS);
        v2u* o8 = (v2u*)(H + (size_t)m * D) + lane;
#pragma unroll
        for (int j = 0; j < 4; ++j) { const int col = 4 * lane + 256 * j;
            const f32x4 gg = *(const f32x4*)(g + col), scv = *(const f32x4*)(sc + col), shv = *(const f32x4*)(sh + col);
            const f32x4 y = v[j] * rstd * gg * (scv + 1.f) + shv;
            v2u w; w.x = pk2(y.x, y.y); w.y = pk2(y.z, y.w); o8[64 * j] = w; }
    }
#undef NR_LOAD
}

__device__ __forceinline__ void sincos_ang(float ang, float& s, float& c) {
    double r = (double)ang * 0.15915494309189535; r -= __builtin_rint(r);
    const float rf = (float)r; s = __builtin_amdgcn_sinf(rf); c = __builtin_amdgcn_cosf(rf);
}
__device__ __forceinline__ unsigned fkey(float f) { const unsigned u = __builtin_bit_cast(unsigned, f); return (u & 0x80000000u) ? ~u : (u | 0x80000000u); }

#ifdef PROBE_ATOM2
#define PROBE_ATOM_EXTRA { LAS unsigned* dq_ = (LAS unsigned*)(lds + 155648) + hf * 1024; lds_add(dq_ + (b0_ >> 1), 1u); lds_add(dq_ + (b1_ >> 1), 1u); }
#else
#define PROBE_ATOM_EXTRA
#endif
constexpr int S_KEYS = 0, S_HIST = 131072, S_SEL = 147456, S_TIE = 149504, S_ST = 153600;
__device__ __forceinline__ unsigned lds_add(LAS unsigned* p, unsigned v) { return __hip_atomic_fetch_add(p, v, __ATOMIC_RELAXED, __HIP_MEMORY_SCOPE_WORKGROUP); }

template <int PASS>
__device__ __forceinline__ void radix_pass(LAS unsigned char* lds, int tid, int wave, int lane, int nchunk  ) {
    constexpr int SHIFT = PASS == 0 ? 21 : (PASS == 1 ? 10 : 0);
    constexpr int BITS = PASS == 2 ? 10 : 11, NBIN = 1 << BITS, PER = NBIN / 64, HISHIFT = (SHIFT + BITS) & 31;
    LAS unsigned* hist = (LAS unsigned*)(lds + S_HIST);
    LAS unsigned* st = (LAS unsigned*)(lds + S_ST);
    if (PASS != 0) { for (int i = tid; i < 1024; i += NTHR) ((LAS v4u*)hist)[i] = (v4u){0u, 0u, 0u, 0u}; }
    __syncthreads();
    if (PASS != 0) {
        const int q = wave >> 1; const unsigned pf = st[q * 8];
        LAS unsigned* hq = hist + q * 1024;
        const LAS v4u* kq = (const LAS v4u*)(lds + S_KEYS + q * 32768);
        for (int c = (wave & 1) * 64 + lane; c < nchunk; c += 128) {
            const v4u k = kq[c];
#pragma unroll
            for (int e = 0; e < 4; ++e) { const unsigned key = k[e];
                if (PASS == 0 ? (key != 0u) : ((key >> HISHIFT) == pf)) { const unsigned bin = (key >> SHIFT) & (NBIN - 1); lds_add(hq + (bin >> 1), 1u << (16 * (bin & 1))); } }
        }
    }
    __syncthreads();
    if (wave < 4) {
        const int q = wave; const unsigned need = st[q * 8 + 1];
        const LAS unsigned* hw = hist + q * 1024 + lane * (PER / 2);
        unsigned s = 0;
#pragma unroll
        for (int e = 0; e < PER / 2; ++e) { const unsigned w = hw[e]; s += (w & 0xffffu) + (w >> 16); }
        unsigned incl = s;
#pragma unroll
        for (int d = 1; d < 64; d <<= 1) { const unsigned o = __shfl_down(incl, d); if (lane + d < 64) incl += o; }
        const unsigned above = incl - s;
        if (PASS == 0) {
            const bool own = above < need && need <= incl;
            const unsigned long long bm = __ballot(own); const int ol = bm ? (int)__builtin_ctzll(bm) : 0;
            const unsigned above_o = (unsigned)__shfl((int)above, ol);
            unsigned hb = 0u;
            if (lane < 32) { const unsigned w = hist[q * 1024 + ol * 16 + (lane >> 1)]; hb = (lane & 1) ? (w >> 16) : (w & 0xffffu); }
            unsigned incl2 = hb;
#pragma unroll
            for (int d = 1; d < 32; d <<= 1) { const unsigned o = __shfl_down(incl2, d); if (lane + d < 32) incl2 += o; }
            const unsigned above2 = above_o + incl2 - hb;
            if (lane < 32 && above2 < need && need <= above2 + hb) { st[q * 8 + 0] = (unsigned)(ol * 32 + lane); st[q * 8 + 1] = need - above2; st[q * 8 + 4] = hb; }
        } else
        if (above < need && need <= incl) {
            unsigned cum = above; int bin = PER - 1; unsigned h = 0;
#pragma unroll 1
            for (;; --bin) { const unsigned w = hw[bin >> 1]; h = (bin & 1) ? (w >> 16) : (w & 0xffffu); if (cum + h >= need || bin == 0) break; cum += h; }
            st[q * 8 + 0] = (PASS == 0 ? 0u : (st[q * 8 + 0] << BITS)) | (unsigned)(lane * PER + bin);
            st[q * 8 + 1] = need - cum;
            st[q * 8 + 4] = h;
        }
    }
    __syncthreads();
}

__device__ __forceinline__ void select_phase(const Params& p, LAS unsigned char* lds, const bf16* PROJ, const bf16* KIb, const float* WIb, unsigned short* SEL, int tid_in) {
    const int G = gridDim.x, cid = blockIdx.x;
    LAS unsigned* st = (LAS unsigned*)(lds + S_ST);
    LAS unsigned short* sel = (LAS unsigned short*)(lds + S_SEL);
    LAS unsigned short* tie = (LAS unsigned short*)(lds + S_TIE);
#define UNIT_DECODE(round_, ok_, b_, t0_) { int ul_; \
    if ((G & 7) == 0) { const int x_ = cid & 7, nl_ = G >> 2, lw_ = (x_ & 1) * (G >> 3) + (cid >> 3); \
        b_ = x_ >> 1; ul_ = (round_) * nl_ + (((round_) & 1) ? (nl_ - 1 - lw_) : lw_); ok_ = ul_ < 1984; } \
    else { const int u_ = (round_) * G + (((round_) & 1) ? (G - 1 - cid) : cid); ok_ = u_ < 4 * 1984; b_ = u_ / 1984; ul_ = u_ % 1984; } \
    t0_ = ul_ * 4 + 256; }
#define AFR_LOAD(b_, t0_) { const size_t mb_ = (size_t)(b_) * T + (t0_); const int r_ = lane & 31, hf_ = lane >> 5; \
    { const int ii = r_ >> 3, hh = (r_ >> 2) & 1, jj = r_ & 3; const int q = 2 * hh + (ii >> 1), h = 4 * (ii & 1) + jj; \
      const bf16* qp = PROJ + (mb_ + q) * NATTP + 1536 + h * 64 + 8 * hf_;     \
      _Pragma("unroll") for (int ks = 0; ks < 4; ++ks) Afr[ks] = *(const bf16x8*)(qp + 16 * ks); afr_pos = p.pos[mb_ + q]; } \
    _Pragma("unroll") for (int ql = 0; ql < 2; ++ql) { const f32x4 a = *(const f32x4*)(WIb + (mb_ + 2 * hf_ + ql) * 8), c = *(const f32x4*)(WIb + (mb_ + 2 * hf_ + ql) * 8 + 4); \
        wq[ql][0] = a.x; wq[ql][1] = a.y; wq[ql][2] = a.z; wq[ql][3] = a.w; wq[ql][4] = c.x; wq[ql][5] = c.y; wq[ql][6] = c.z; wq[ql][7] = c.w; } }
    bf16x8 Afr[4]; float wq[2][8]; int afr_pos = 0;
#define AFR_ROPE() { const float posf_ = (float)afr_pos; const int hf_ = lane >> 5; \
    _Pragma("unroll") for (int ks = 0; ks < 2; ++ks) { const v4u lo_ = __builtin_bit_cast(v4u, Afr[ks]), hi_ = __builtin_bit_cast(v4u, Afr[ks + 2]); v4u ol_, oh_; \
        _Pragma("unroll") for (int w_ = 0; w_ < 4; ++w_) { const unsigned lw_ = lo_[w_], hw_ = hi_[w_]; float ro_[2][2]; \
            _Pragma("unroll") for (int z_ = 0; z_ < 2; ++z_) { const float xl_ = z_ ? bf2f(lw_ >> 16) : bf2f(lw_ & 0xffffu), xh_ = z_ ? bf2f(hw_ >> 16) : bf2f(hw_ & 0xffffu); \
                float sn_, cs_; sincos_ang(posf_ * p.inv_freq[16 * ks + 8 * hf_ + 2 * w_ + z_], sn_, cs_); ro_[0][z_] = xl_ * cs_ - xh_ * sn_; ro_[1][z_] = xh_ * cs_ + xl_ * sn_; } \
            ol_[w_] = pk2(ro_[0][0], ro_[0][1]); oh_[w_] = pk2(ro_[1][0], ro_[1][1]); } \
        Afr[ks] = __builtin_bit_cast(bf16x8, ol_); Afr[ks + 2] = __builtin_bit_cast(bf16x8, oh_); } }
    bool ok_n; int b_n, t0_n;
    UNIT_DECODE(0, ok_n, b_n, t0_n)
    { int tid = tid_in; asm volatile("" : "+v"(tid)); const int lane = tid & 63; if (ok_n) AFR_LOAD(b_n, t0_n) }
    for (int round = 0;; ++round) {
        int tid = tid_in; asm volatile("" : "+v"(tid));
        const int lane = tid & 63, wave = __builtin_amdgcn_readfirstlane(tid >> 6);
        if (!ok_n) break;
        const int b = b_n, t0 = t0_n; const size_t mbase = (size_t)b * T + t0;
        const int ntiles = ((t0 + 3) >> 5) + 1, nround = (ntiles + 31) & ~31;
        for (int i = tid; i < 1024; i += NTHR) ((LAS v4u*)(lds + S_HIST))[i] = (v4u){0u, 0u, 0u, 0u};
        if (tid < 4) { st[tid * 8 + 0] = 0u; st[tid * 8 + 1] = 256u; st[tid * 8 + 2] = 0u; st[tid * 8 + 3] = 0u; st[tid * 8 + 5] = 0u; st[tid * 8 + 6] = 0u; }
        __syncthreads();
#ifdef PROBE_IDX2
        for (int rep_ = 0; rep_ < 2; ++rep_)
#endif
        {
            const int r = lane & 31, hf = lane >> 5;
            const int tA = t0 + 2 * hf;
            const bf16* kbase = KIb + (size_t)b * T * 64 + lane * 8;
            LAS unsigned* kw0 = (LAS unsigned*)(lds + S_KEYS + (2 * hf) * 32768) + r; LAS unsigned* kw1 = kw0 + 8192;
            LAS unsigned* hq0 = (LAS unsigned*)(lds + S_HIST) + (2 * hf) * 1024; LAS unsigned* hdum = (LAS unsigned*)(lds + S_ST + 128) + lane;
            bf16x8 R0[4], R1[4], R2[4], R3[4];
#define IDX_LOAD(R, ktv) { const int ktc_ = (ktv) < ntiles ? (ktv) : (ntiles - 1); const bf16* kp_ = kbase + (size_t)ktc_ * 2048; \
    R[0] = *(const bf16x8*)(kp_); R[1] = *(const bf16x8*)(kp_ + 512); R[2] = *(const bf16x8*)(kp_ + 1024); R[3] = *(const bf16x8*)(kp_ + 1536); }
#define IDX_MMA(ACC, R, ktv) if ((ktv) < ntiles) { _Pragma("unroll") for (int e_ = 0; e_ < 16; ++e_) ACC[e_] = 0.f; \
    ACC = __builtin_amdgcn_mfma_f32_32x32x16_bf16(Afr[0], R[0], ACC, 0, 0, 0); ACC = __builtin_amdgcn_mfma_f32_32x32x16_bf16(Afr[1], R[1], ACC, 0, 0, 0); \
    ACC = __builtin_amdgcn_mfma_f32_32x32x16_bf16(Afr[2], R[2], ACC, 0, 0, 0); ACC = __builtin_amdgcn_mfma_f32_32x32x16_bf16(Afr[3], R[3], ACC, 0, 0, 0); }
#define IDX_POST(ACC, ktv) if ((ktv) >= 0 && (ktv) < ntiles) { float s0_ = 0.f, s1_ = 0.f; \
    _Pragma("unroll") for (int i4_ = 0; i4_ < 4; ++i4_) _Pragma("unroll") for (int j_ = 0; j_ < 4; ++j_) { const float a_ = ACC[4 * i4_ + j_]; const int vi_ = __float_as_int(a_); const float v_ = __int_as_float(vi_ > 0 ? vi_ : 0); const int h_ = 4 * (i4_ & 1) + j_; \
        if (i4_ >> 1) s1_ = __builtin_fmaf(wq[1][h_], v_, s1_); else s0_ = __builtin_fmaf(wq[0][h_], v_, s0_); } \
    const int s_ = 32 * (ktv) + r; const unsigned k0_ = (s_ <= tA) ? fkey(s0_) : 0u, k1_ = (s_ <= tA + 1) ? fkey(s1_) : 0u; kw0[32 * (ktv)] = k0_; kw1[32 * (ktv)] = k1_; \
    { const unsigned b0_ = k0_ >> 21, b1_ = k1_ >> 21; \
      lds_add(k0_ ? hq0 + (b0_ >> 1) : hdum, k0_ ? (1u << (16 * (b0_ & 1))) : 0u); lds_add(k1_ ? hq0 + 1024 + (b1_ >> 1) : hdum, k1_ ? (1u << (16 * (b1_ & 1))) : 0u); } }
            f32x16 accA, accB;
#pragma unroll
            for (int e = 0; e < 16; ++e) { accA[e] = 0.f; accB[e] = 0.f; }
            __builtin_amdgcn_sched_barrier(0); IDX_LOAD(R0, wave) __builtin_amdgcn_sched_barrier(0); IDX_LOAD(R1, wave + 8) __builtin_amdgcn_sched_barrier(0); IDX_LOAD(R2, wave + 16) __builtin_amdgcn_sched_barrier(0);
            int kt = wave;
            for (; kt < nround; kt += 32) {
                IDX_LOAD(R3, kt + 24) __builtin_amdgcn_sched_barrier(0); IDX_MMA(accA, R0, kt) IDX_POST(accB, kt - 8) __builtin_amdgcn_sched_barrier(0);
                IDX_LOAD(R0, kt + 32) __builtin_amdgcn_sched_barrier(0); IDX_MMA(accB, R1, kt + 8) IDX_POST(accA, kt) __builtin_amdgcn_sched_barrier(0);
                IDX_LOAD(R1, kt + 40) __builtin_amdgcn_sched_barrier(0); IDX_MMA(accA, R2, kt + 16) IDX_POST(accB, kt + 8) __builtin_amdgcn_sched_barrier(0);
                IDX_LOAD(R2, kt + 48) __builtin_amdgcn_sched_barrier(0); IDX_MMA(accB, R3, kt + 24) IDX_POST(accA, kt + 16) __builtin_amdgcn_sched_barrier(0);
            }
            IDX_POST(accB, kt - 8)
#undef IDX_MMA
#undef IDX_POST
#undef IDX_LOAD
        }
        UNIT_DECODE(round + 1, ok_n, b_n, t0_n)
        if (ok_n) AFR_LOAD(b_n, t0_n)
        const int nchunk = ntiles * 8;
        radix_pass<0>(lds, tid, wave, lane, nchunk);
#ifdef PROBE_RAD2
        if (tid < 4) { st[tid * 8 + 0] = 0u; st[tid * 8 + 1] = 256u; }
        radix_pass<0>(lds, tid, wave, lane, nchunk);
#endif
        LAS unsigned* ckey = (LAS unsigned*)(lds + S_HIST); LAS unsigned short* cidx = (LAS unsigned short*)(lds + S_HIST + 8192); LAS unsigned* shist = (LAS unsigned*)(lds + S_HIST + 12288);
        {
            const int q = wave >> 1; const unsigned Bq = st[q * 8];
            const LAS v4u* kq = (const LAS v4u*)(lds + S_KEYS + q * 32768);
            unsigned cnt = 0u;
            for (int c = (wave & 1) * 64 + lane; c < nchunk; c += 128) {
                const v4u k = kq[c];
#pragma unroll
                for (int e = 0; e < 4; ++e) { const unsigned bin = k[e] >> 21; cnt += (bin > Bq ? 1u : 0u) + (bin == Bq ? 0x10000u : 0u); }
            }
            unsigned incl = cnt;
#pragma unroll
            for (int d = 1; d < 64; d <<= 1) { const unsigned o = __shfl_up(incl, d); if (lane >= d) incl += o; }
            const unsigned excl = incl - cnt, tot = (unsigned)__shfl((int)incl, 63);
            unsigned baseA = 0u, baseC = 0u;
            if (lane == 0) { baseA = lds_add(&st[q * 8 + 2], tot & 0xffffu); baseC = lds_add(&st[q * 8 + 5], tot >> 16); }
            baseA = (unsigned)__shfl((int)baseA, 0); baseC = (unsigned)__shfl((int)baseC, 0);
            unsigned pa = baseA + (excl & 0xffffu), pc = baseC + (excl >> 16);
            for (int c = (wave & 1) * 64 + lane; c < nchunk; c += 128) {
                const v4u k = kq[c];
#pragma unroll
                for (int e = 0; e < 4; ++e) { const unsigned key = k[e]; const unsigned bin = key >> 21; const unsigned short s = (unsigned short)(4 * c + e);
                    if (bin > Bq) { sel[q * 256 + (pa & 255u)] = s; ++pa; }
                    else if (bin == Bq) { if (pc < 512u) { ckey[q * 512 + pc] = key; cidx[q * 512 + pc] = s; } ++pc; } }
            }
        }
        __syncthreads();
        const bool small = st[4] <= 512u && st[12] <= 512u && st[20] <= 512u && st[28] <= 512u;
        if (small) {
            if (wave < 4) {
                const int q = wave; const int n = (int)st[q * 8 + 5]; unsigned need = st[q * 8 + 1], cpf = 0u, cnt_eq = 0u;
                LAS unsigned* sh = shist + q * 128;
#pragma unroll
                for (int ps = 0; ps < 3; ++ps) {
                    const int shift = 14 - 7 * ps;
#define WAVE_LDS_FENCE() { __builtin_amdgcn_fence(__ATOMIC_SEQ_CST, "workgroup"); __builtin_amdgcn_wave_barrier(); }
                    WAVE_LDS_FENCE()
                    sh[2 * lane] = 0u; sh[2 * lane + 1] = 0u;
                    WAVE_LDS_FENCE()
                    for (int i = lane; i < n; i += 64) { const unsigned low = ckey[q * 512 + i] & 0x1fffffu;
                        if (ps == 0 || (low >> (shift + 7)) == cpf) lds_add(sh + ((low >> shift) & 127u), 1u); }
                    WAVE_LDS_FENCE()
                    const unsigned h0 = sh[2 * lane], h1 = sh[2 * lane + 1];
                    const unsigned sm = h0 + h1; unsigned incl = sm;
#pragma unroll
                    for (int d = 1; d < 64; d <<= 1) { const unsigned o = __shfl_down(incl, d); if (lane + d < 64) incl += o; }
                    const unsigned above = incl - sm;
                    const bool own = above < need && need <= incl;
                    const unsigned long long bm = __ballot(own); const int ol = bm ? (int)__builtin_ctzll(bm) : 0;
                    const bool top = above + h1 >= need;
                    const unsigned nbin = (unsigned)(2 * lane + (top ? 1 : 0)), nneed = need - (top ? above : above + h1), neq = top ? h1 : h0;
                    cpf = (cpf << 7) | (unsigned)__shfl((int)nbin, ol); need = (unsigned)__shfl((int)nneed, ol); cnt_eq = (unsigned)__shfl((int)neq, ol);
                }
                const unsigned Tq = (st[q * 8] << 21) | cpf; const bool allq = need == cnt_eq;
                for (int i = lane; i < n; i += 64) { const unsigned key = ckey[q * 512 + i];
                    if (key >= Tq) { const unsigned short s2 = cidx[q * 512 + i];
                        if (key > Tq || allq) { const unsigned pos = lds_add(&st[q * 8 + 2], 1u); sel[q * 256 + (pos & 255u)] = s2; }
                        else { const unsigned pos = lds_add(&st[q * 8 + 3], 1u); if (pos < 512u) tie[q * 512 + pos] = s2; } } }
                if (lane == 0) st[q * 8 + 1] = need;
            }
        } else {
            if (tid < 4) st[tid * 8 + 2] = 0u;
            radix_pass<1>(lds, tid, wave, lane, nchunk);
            radix_pass<2>(lds, tid, wave, lane, nchunk);
            {
                const int q = wave >> 1; const unsigned Tq = st[q * 8]; const bool allq = st[q * 8 + 1] == st[q * 8 + 4];
                const LAS v4u* kq = (const LAS v4u*)(lds + S_KEYS + q * 32768);
                for (int c = (wave & 1) * 64 + lane; c < nchunk; c += 128) {
                    const v4u k = kq[c];
    #pragma unroll
                    for (int e = 0; e < 4; ++e) { const unsigned key = k[e];
                        if (key >= Tq) { const unsigned short s = (unsigned short)(4 * c + e);
                            if (key > Tq || allq) { const unsigned pos = lds_add(&st[q * 8 + 2], 1u); sel[q * 256 + (pos & 255u)] = s; }
                            else { const unsigned pos = lds_add(&st[q * 8 + 3], 1u); if (pos < 512u) tie[q * 512 + pos] = s; } } }
                }
            }
        }
        __syncthreads();
        if (wave < 4) {
            const int q = wave; unsigned ntie = st[q * 8 + 3]; ntie = ntie < 512u ? ntie : 512u;
            if (ntie > 0u) { const unsigned need_eq = st[q * 8 + 1];
                for (unsigned e = lane; e < ntie; e += 64) { const unsigned my = tie[q * 512 + e]; unsigned rank = 0;
                    for (unsigned f = 0; f < ntie; ++f) rank += (tie[q * 512 + f] < my) ? 1u : 0u;
                    if (rank < need_eq) { const unsigned pos = lds_add(&st[q * 8 + 2], 1u); sel[q * 256 + (pos & 255u)] = (unsigned short)my; } } }
        }
        __syncthreads();
        ((unsigned*)(SEL + mbase * 256))[tid] = ((const LAS unsigned*)sel)[tid];
        __syncthreads();
    }
#undef UNIT_DECODE
#undef AFR_LOAD
#undef AFR_ROPE
}

typedef short v4i16_t __attribute__((ext_vector_type(4)));
__device__ __forceinline__ void gather_attn_phase(const Params& p, LAS unsigned char* lds, const bf16* PROJ, const bf16* Kb, const bf16* Vb, const unsigned short* SEL, bf16* Ob, int tid_in) {
    int tid = tid_in; asm volatile("" : "+v"(tid));
    const int lane = tid & 63, wave = __builtin_amdgcn_readfirstlane(tid >> 6);
    const int G = gridDim.x, ngroups = (G & 7) ? 1 : 8;
    const int x = blockIdx.x % ngroups, wix = (blockIdx.x / ngroups) * NWAVES + wave, nwx = (G / ngroups) * NWAVES;
    LAS unsigned char* img = lds + wave * 16384;
    LAS unsigned short* slb0 = (LAS unsigned short*)(lds + 131072 + wave * 1024); LAS unsigned short* slb1 = slb0 + 256;
    const int n16 = lane & 15, kg = lane >> 4, vrow = lane >> 3, vch = lane & 7;
    const int qq = (lane & 15) >> 2, pp = lane & 3;
    unsigned roff[4][2], kroff[2][2], klc[4], vlc[4];
#pragma unroll
    for (int i = 0; i < 4; ++i) { const int row = 8 * i + vrow; klc[i] = 16 * (vch ^ ((row ^ (row >> 3)) & 7)); vlc[i] = 16 * (2 * ((vch >> 1) ^ ((row >> 1) & 3)) + (vch & 1)); }
#pragma unroll
    for (int c = 0; c < 4; ++c)
#pragma unroll
        for (int tt = 0; tt < 2; ++tt) { const int row = 16 * tt + 4 * kg + qq; roff[c][tt] = 4096 + row * 128 + 32 * (c ^ ((row >> 1) & 3)) + 8 * pp; }
#pragma unroll
    for (int blk = 0; blk < 2; ++blk)
#pragma unroll
        for (int ks = 0; ks < 2; ++ks) { const int row = 16 * blk + n16; kroff[blk][ks] = row * 128 + 16 * ((kg + 4 * ks) ^ ((row ^ (row >> 3)) & 7)); }
    const int nq = (T - wix + nwx - 1) / nwx, npair = (16 - x + ngroups - 1) / ngroups, ntask = nq * npair;
    if (ntask <= 0) return;
#define TASK(i_, b_, g_, t_) const int pi_##b_ = x + ngroups * ((i_) / nq); const int b_ = pi_##b_ >> 2, g_ = pi_##b_ & 3, t_ = wix + nwx * ((i_) % nq);
#define SEL_LOAD(sv_, b_, t_) { v2u ld_ = *(const v2u*)(SEL + ((size_t)(b_) * T + (t_)) * 256 + 4 * lane); \
    v2u id_; id_.x = (unsigned)(4 * lane) | ((unsigned)(4 * lane + 1) << 16); id_.y = (unsigned)(4 * lane + 2) | ((unsigned)(4 * lane + 3) << 16); \
    sv_.x = (t_) >= 256 ? ld_.x : id_.x; sv_.y = (t_) >= 256 ? ld_.y : id_.y; }
#define Q_RAW(rq_, pos_, b_, g_, t_) { const size_t mq_ = (size_t)(b_) * T + (t_); const bf16* qp_ = PROJ + mq_ * NATTP + (4 * (g_) + (n16 & 3)) * 64 + 8 * kg; \
    rq_[0] = *(const v4u*)qp_; rq_[1] = *(const v4u*)(qp_ + 32); }
#define Q_FINISH(Bq_, rq_, pos_) { const v4u z_ = {0u, 0u, 0u, 0u}; (void)(pos_); Bq_[0] = __builtin_bit_cast(bf16x8, (n16 < 4) ? rq_[0] : z_); Bq_[1] = __builtin_bit_cast(bf16x8, (n16 < 4) ? rq_[1] : z_); }
#define SELX(S_, k_) ((int)((S_[(k_) >> 3][((k_) >> 1) & 3] >> (16 * ((k_) & 1))) & 0xffffu))
#define CH_DMA(buf, ch, S_, Kg_, Vg_) { \
    _Pragma("unroll") for (int i_ = 0; i_ < 4; ++i_) { const int sv2_ = SELX(S_, (ch) * 4 + i_); \
        __builtin_amdgcn_global_load_lds((const unsigned*)((Kg_) + (size_t)sv2_ * 512 + klc[i_]), (LAS unsigned*)(img + (buf) * 8192 + i_ * 1024), 16, 0, 0); \
        __builtin_amdgcn_global_load_lds((const unsigned*)((Vg_) + (size_t)sv2_ * 512 + vlc[i_]), (LAS unsigned*)(img + (buf) * 8192 + 4096 + i_ * 1024), 16, 0, 0); } }
#define SEL_REGS(S_, slp_) { _Pragma("unroll") for (int j_ = 0; j_ < 4; ++j_) S_[j_] = ((const LAS v4u*)((slp_) + vrow * 32))[j_]; }
    v4u selc[4], seln[4]; v4u rqn[2]; int posn = 0;
    float qgl[8], qgh[8], qinvf[8];
#pragma unroll
    for (int e = 0; e < 8; ++e) { qgl[e] = p.qg[8 * kg + e]; qgh[e] = p.qg[32 + 8 * kg + e]; qinvf[e] = p.inv_freq[8 * kg + e]; }
    bf16x8 Bq[2], Bqn[2]; v2u svn;
    {
        TASK(0, b0, g0, t0)
        SEL_LOAD(svn, b0, t0) *(LAS v2u*)(slb0 + 4 * lane) = svn;
        Q_RAW(rqn, posn, b0, g0, t0) Q_FINISH(Bq, rqn, posn)
        const char* Kg0 = (const char*)(Kb + (size_t)b0 * T * 256 + g0 * 64); const char* Vg0 = (const char*)(Vb + (size_t)b0 * T * 256 + g0 * 64);
        asm volatile("s_waitcnt lgkmcnt(0)" ::: "memory");
        SEL_REGS(selc, slb0)
        CH_DMA(0, 0, selc, Kg0, Vg0)
    }
    for (int i = 0; i < ntask; ++i) {
        LAS unsigned short* slc = (i & 1) ? slb1 : slb0; LAS unsigned short* sln = (i & 1) ? slb0 : slb1;
        TASK(i, b, g, t)
        const int inx = (i + 1 < ntask) ? i + 1 : i;
        TASK(inx, bn, gn, tn)
        const char* Kg = (const char*)(Kb + (size_t)b * T * 256 + g * 64); const char* Vg = (const char*)(Vb + (size_t)b * T * 256 + g * 64);
        const char* Kgn = (const char*)(Kb + (size_t)bn * T * 256 + gn * 64); const char* Vgn = (const char*)(Vb + (size_t)bn * T * 256 + gn * 64);
        const size_t m = (size_t)b * T + t;
        const int nsel = t < 255 ? t + 1 : 256;
        f32x4 Oacc[4];
#pragma unroll
        for (int c = 0; c < 4; ++c) Oacc[c] = (f32x4){0.f, 0.f, 0.f, 0.f};
        float lsum = 0.f;
#pragma unroll
        for (int ch = 0; ch < 8; ++ch) {
            if (ch == 0) { SEL_LOAD(svn, bn, tn) Q_RAW(rqn, posn, bn, gn, tn) }
            if (ch == 5) Q_FINISH(Bqn, rqn, posn)
            if (ch == 4) *(LAS v2u*)(sln + 4 * lane) = svn;
            if (ch == 6) { asm volatile("s_waitcnt lgkmcnt(0)" ::: "memory"); SEL_REGS(seln, sln) }
            if (ch < 7) CH_DMA((ch + 1) & 1, ch + 1, selc, Kg, Vg) else CH_DMA(0, 0, seln, Kgn, Vgn)
            asm volatile("s_waitcnt vmcnt(8)" ::: "memory");
            const int cb = ch & 1;
            LAS unsigned char* kst = img + cb * 8192; LAS unsigned char* vst = kst;
            const bf16x8 Ka0 = *(const LAS bf16x8*)(kst + kroff[0][0]), Ka1 = *(const LAS bf16x8*)(kst + kroff[0][1]), Ka2 = *(const LAS bf16x8*)(kst + kroff[1][0]), Ka3 = *(const LAS bf16x8*)(kst + kroff[1][1]);
            __builtin_amdgcn_sched_barrier(0);
            f32x4 S0 = {0.f, 0.f, 0.f, 0.f}, S1 = {0.f, 0.f, 0.f, 0.f};
            S0 = __builtin_amdgcn_mfma_f32_16x16x32_bf16(Ka0, Bq[0], S0, 0, 0, 0); S0 = __builtin_amdgcn_mfma_f32_16x16x32_bf16(Ka1, Bq[1], S0, 0, 0, 0);
            S1 = __builtin_amdgcn_mfma_f32_16x16x32_bf16(Ka2, Bq[0], S1, 0, 0, 0); S1 = __builtin_amdgcn_mfma_f32_16x16x32_bf16(Ka3, Bq[1], S1, 0, 0, 0);
            float p0[4], p1[4];
#pragma unroll
            for (int jj = 0; jj < 4; ++jj) { const int r0 = 4 * kg + jj, r1 = 16 + 4 * kg + jj;
                const int j0 = (r0 & 7) * 32 + ch * 4 + (r0 >> 3), j1 = (r1 & 7) * 32 + ch * 4 + (r1 >> 3);
                p0[jj] = (j0 < nsel) ? __builtin_amdgcn_exp2f(S0[jj]) : 0.f; p1[jj] = (j1 < nsel) ? __builtin_amdgcn_exp2f(S1[jj]) : 0.f; lsum += p0[jj] + p1[jj]; }
            v4u aw; aw.x = pk2(p0[0], p0[1]); aw.y = pk2(p0[2], p0[3]); aw.z = pk2(p1[0], p1[1]); aw.w = pk2(p1[2], p1[3]);
            const bf16x8 Ap = __builtin_bit_cast(bf16x8, aw);
            {
                v2u tr[4][2]; const unsigned vb = (unsigned)(__UINTPTR_TYPE__)vst;
                asm volatile("ds_read_b64_tr_b16 %0, %8\n\tds_read_b64_tr_b16 %1, %9\n\tds_read_b64_tr_b16 %2, %10\n\tds_read_b64_tr_b16 %3, %11\n\t"
                             "ds_read_b64_tr_b16 %4, %12\n\tds_read_b64_tr_b16 %5, %13\n\tds_read_b64_tr_b16 %6, %14\n\tds_read_b64_tr_b16 %7, %15\n\ts_waitcnt lgkmcnt(0)"
                             : "=&v"(tr[0][0]), "=&v"(tr[0][1]), "=&v"(tr[1][0]), "=&v"(tr[1][1]), "=&v"(tr[2][0]), "=&v"(tr[2][1]), "=&v"(tr[3][0]), "=&v"(tr[3][1])
                             : "v"(vb + roff[0][0]), "v"(vb + roff[0][1]), "v"(vb + roff[1][0]), "v"(vb + roff[1][1]), "v"(vb + roff[2][0]), "v"(vb + roff[2][1]), "v"(vb + roff[3][0]), "v"(vb + roff[3][1])
                             : "memory");
#pragma unroll
                for (int c = 0; c < 4; ++c) { v4u bw; bw.x = tr[c][0].x; bw.y = tr[c][0].y; bw.z = tr[c][1].x; bw.w = tr[c][1].y;
                    Oacc[c] = __builtin_amdgcn_mfma_f32_16x16x32_bf16(Ap, __builtin_bit_cast(bf16x8, bw), Oacc[c], 0, 0, 0); }
            }
        }
        Bq[0] = Bqn[0]; Bq[1] = Bqn[1];
#pragma unroll
        for (int j = 0; j < 4; ++j) selc[j] = seln[j];
        lsum += __shfl_xor(lsum, 16); lsum += __shfl_xor(lsum, 32);
        float linv[4];
#pragma unroll
        for (int j = 0; j < 4; ++j) linv[j] = 1.f / __shfl(lsum, j);
        if (lane < 16) {
#pragma unroll
            for (int c = 0; c < 4; ++c)
#pragma unroll
                for (int j = 0; j < 4; ++j) Ob[m * 1024 + (4 * g + j) * 64 + 16 * c + lane] = (bf16)f2bf(Oacc[c][j] * linv[j]);
        }
    }
#undef TASK
#undef SEL_LOAD
#undef Q_RAW
#undef Q_FINISH
#undef CH_LOAD
}

__device__ __forceinline__ float sum16(float v) { v += __shfl_xor(v, 1); v += __shfl_xor(v, 2); v += __shfl_xor(v, 4); v += __shfl_xor(v, 8); return v; }
__device__ __forceinline__ void rope_phase(const Params& p, const bf16* PROJ, bf16* Qb, bf16* Kb, bf16* Vb, bf16* QIb, bf16* KIb, float* WIb, int tid_in) {
    int tid = tid_in; asm volatile("" : "+v"(tid));
    const int lane = tid & 63, gw = blockIdx.x * NWAVES + __builtin_amdgcn_readfirstlane(tid >> 6), ngw = gridDim.x * NWAVES;
    const int hs = lane >> 4, d4 = lane & 15, d0 = 4 * d4;
    float invf[4], qgl[4], kgl[4], lg[4], lb[4];
#pragma unroll
    for (int e = 0; e < 4; ++e) { invf[e] = p.inv_freq[(d0 + e) & 31]; qgl[e] = p.qg[d0 + e]; kgl[e] = p.kg[d0 + e]; lg[e] = p.lng[d0 + e]; lb[e] = p.lnb[d0 + e]; }
    const float sg = (d4 < 8) ? -1.f : 1.f;
    for (int m = gw; m < M; m += ngw) {
        const float posf = (float)p.pos[m];
        float cs[4], sn[4];
#pragma unroll
        for (int e = 0; e < 4; ++e) { float s_, c_; sincos_ang(posf * invf[e], s_, c_); cs[e] = c_; sn[e] = s_ * sg; }
        const bf16* pr = PROJ + (size_t)m * NATTP;
#define LD4(v, ptr) { const v2u w_ = *(const v2u*)(ptr); v[0] = bf2f(w_.x & 0xffffu); v[1] = bf2f(w_.x >> 16); v[2] = bf2f(w_.y & 0xffffu); v[3] = bf2f(w_.y >> 16); }
#define ROPE_ST4(dst, y, scale) { float o_[4]; _Pragma("unroll") for (int e_ = 0; e_ < 4; ++e_) { const float pp_ = __shfl_xor(y[e_], 8); o_[e_] = (y[e_] * cs[e_] + pp_ * sn[e_]) * (scale); } \
    v2u w_; w_.x = pk2(o_[0], o_[1]); w_.y = pk2(o_[2], o_[3]); *(v2u*)(dst) = w_; }
        {
            float v[4]; LD4(v, pr + 1024 + hs * 64 + d0)
            const float ss = sum16((v[0] * v[0] + v[1] * v[1]) + (v[2] * v[2] + v[3] * v[3]));
            const float rs = rsqrtf(ss * (1.f / 64.f) + EPS);
            float y[4];
#pragma unroll
            for (int e = 0; e < 4; ++e) y[e] = v[e] * rs * kgl[e];
            ROPE_ST4(Kb + (size_t)m * 256 + hs * 64 + d0, y, 1.f)
            *(v2u*)(Vb + (size_t)m * 256 + hs * 64 + d0) = *(const v2u*)(pr + 1280 + hs * 64 + d0);
        }
        {
            float v[4]; LD4(v, pr + 2048 + d0)
            const float mu = sum16((v[0] + v[1]) + (v[2] + v[3])) * (1.f / 64.f);
            float dv[4];
#pragma unroll
            for (int e = 0; e < 4; ++e) dv[e] = v[e] - mu;
            const float var = sum16((dv[0] * dv[0] + dv[1] * dv[1]) + (dv[2] * dv[2] + dv[3] * dv[3])) * (1.f / 64.f);
            const float rs = rsqrtf(var + EPS);
            float y[4], o[4];
#pragma unroll
            for (int e = 0; e < 4; ++e) y[e] = dv[e] * rs * lg[e] + lb[e];
#pragma unroll
            for (int e = 0; e < 4; ++e) { const float pp = __shfl_xor(y[e], 8); o[e] = y[e] * cs[e] + pp * sn[e]; }
            const int sq = m & (T - 1);
            if (hs == 0) { v2u w; w.x = pk2(o[0], o[1]); w.y = pk2(o[2], o[3]);
                *(v2u*)(KIb + (size_t)(m - sq) * 64 + (sq >> 5) * 2048 + (d0 >> 4) * 512 + (((d0 >> 3) & 1) * 32 + (sq & 31)) * 8 + (d0 & 7)) = w; }
        }
        if (lane < 8) WIb[(size_t)m * 8 + lane] = bf2f(pr[2112 + lane]) * 0.04419417382415922f;
#undef LD4
#undef ROPE_ST4
    }
}

__device__ __forceinline__ void conv_phase(const float* cw, const bf16* Zb, bf16* Gb, int tid_in) {
    int tid = tid_in; asm volatile("" : "+v"(tid));
    const int lane = tid & 63, gw = blockIdx.x * NWAVES + __builtin_amdgcn_readfirstlane(tid >> 6), ngw = gridDim.x * NWAVES;
    const bf16* Bgp = Zb + (size_t)M * D;
    for (int m = gw; m < M; m += ngw) {
        const int t = m & (T - 1);
#pragma unroll
        for (int jp = 0; jp < 2; ++jp) {
            const int col = 8 * lane + 512 * jp;
            float accv[8];
#pragma unroll
            for (int e = 0; e < 8; ++e) accv[e] = 0.f;
#pragma unroll
            for (int w = 0; w < 3; ++w) {
                const int dt = 2 - w;
                const bool ok = t - dt >= 0; const float wz = ok ? 1.f : 0.f;
                const v4u zz = *(const v4u*)(Zb + (size_t)(ok ? m - dt : m) * D + col);
                const f32x4 w0 = *(const f32x4*)(cw + w * 1024 + col) * wz, w1 = *(const f32x4*)(cw + w * 1024 + col + 4) * wz;
                accv[0] += w0.x * bf2f(zz.x & 0xffffu); accv[1] += w0.y * bf2f(zz.x >> 16); accv[2] += w0.z * bf2f(zz.y & 0xffffu); accv[3] += w0.w * bf2f(zz.y >> 16);
                accv[4] += w1.x * bf2f(zz.z & 0xffffu); accv[5] += w1.y * bf2f(zz.z >> 16); accv[6] += w1.z * bf2f(zz.w & 0xffffu); accv[7] += w1.w * bf2f(zz.w >> 16);
            }
            const v4u bb = *(const v4u*)(Bgp + (size_t)m * D + col);
            v4u o;
            o.x = pk2(accv[0] * bf2f(bb.x & 0xffffu), accv[1] * bf2f(bb.x >> 16)); o.y = pk2(accv[2] * bf2f(bb.y & 0xffffu), accv[3] * bf2f(bb.y >> 16));
            o.z = pk2(accv[4] * bf2f(bb.z & 0xffffu), accv[5] * bf2f(bb.z >> 16)); o.w = pk2(accv[6] * bf2f(bb.w & 0xffffu), accv[7] * bf2f(bb.w >> 16));
            *(v4u*)(Gb + (size_t)m * D + col) = o;
        }
    }
}


template <int l>
__device__ __forceinline__ void run_layer(const Params& p, LAS unsigned char* lds, const XcdBarrier& bar) {
    const int G = gridDim.x;
    unsigned char* ws = p.ws;
    bf16* Watt = (bf16*)(ws + WS_WATT); bf16* Wao = (bf16*)(ws + WS_WAO); bf16* Wci = (bf16*)(ws + WS_WCI); bf16* Wco = (bf16*)(ws + WS_WCO);
    float* modv = (float*)(ws + WS_MOD);
    bf16* H = (bf16*)(ws + WS_H); bf16* R1 = (bf16*)(ws + WS_R1);
    bf16* Qb = (bf16*)(ws + WS_Q); bf16* QIb = (bf16*)(ws + WS_QI); bf16* Kb = (bf16*)(ws + WS_K); bf16* Vb = (bf16*)(ws + WS_V); bf16* KIb = (bf16*)(ws + WS_KI);
    float* WIb = (float*)(ws + WS_WI); unsigned short* SELb = (unsigned short*)(ws + WS_SEL);
        const float* modl = modv + (size_t)l * 4 * 6144;
        bf16* XR = (bf16*)(ws + WS_XR);
        if (l == 0) norm_rows<false>(p.x, H, p.n1g, modl, 0, threadIdx.x); else norm_rows<true>(XR, H, p.n1g + 1024, modl, 0, threadIdx.x);
#ifdef PROBE_SYNC10
        for (int r_ = 0; r_ < 5; ++r_) xcd_barrier(bar);
#endif
        xcd_barrier(bar);
        { const int N = l == 0 ? NATTP : NCI;
          pg8::Gemm g{H, l == 0 ? Watt : Wci, M, N, 1024}; pg8::StaticOrder S; S.init(M, N, G, (int)blockIdx.x);
          if (l == 0) { EpiAttnIn E{R1, N, ws}; pg8::gemm_phase<EpiAttnIn, pg8::StaticOrder, true, true>(lds, g, S, E); }
          else { EpiConvIn E{R1, R1 + (size_t)M * D}; pg8::gemm_phase<EpiConvIn, pg8::StaticOrder, true, true>(lds, g, S, E); } }
        xcd_barrier(bar);
        if (l == 0) {
#ifndef NO_ATTN
            select_phase(p, lds, R1, KIb, WIb, SELb, threadIdx.x);
#ifdef PROBE_SEL2
            select_phase(p, lds, R1, KIb, WIb, SELb, threadIdx.x);
#endif
            xcd_barrier(bar);
            gather_attn_phase(p, lds, R1, Kb, Vb, SELb, Qb  , threadIdx.x);
#else
            for (size_t i = (size_t)blockIdx.x * NTHR + tid; i < (size_t)M * D / 8; i += (size_t)G * NTHR) ((v4u*)R1)[i] = (v4u){0u, 0u, 0u, 0u};
#endif
        } else {
            conv_phase(p.conv_w, R1, Qb  , threadIdx.x);
#ifdef PROBE_MISC2
            conv_phase(p.conv_w, R1, Qb, threadIdx.x);
#endif
        }
        xcd_barrier(bar);
        { pg8::Gemm g{Qb, l == 0 ? Wao : Wco, M, 1024, 1024}; pg8::StaticOrder S; S.init(M, 1024, G, (int)blockIdx.x);
          if (l == 0) { EpiResid<false, true> E{p.x, XR, modl + 2 * 1024}; pg8::gemm_phase<EpiResid<false, true>, pg8::StaticOrder, true, true>(lds, g, S, E); }
          else { EpiResid<true, true> E{XR, XR, modl + 2 * 1024}; pg8::gemm_phase<EpiResid<true, true>, pg8::StaticOrder, true, true>(lds, g, S, E); } }
        xcd_barrier(bar);
        norm_rows<true>(XR, H, p.n2g + l * 1024, modl, 3, threadIdx.x);
        xcd_barrier(bar);
        { pg8::Gemm g{H, (const bf16*)(ws + (l ? WS_WGU1 : WS_WGU0)), M, NGU, 1024}; pg8::StaticOrder S; S.init(M, NGU, G, (int)blockIdx.x);
          EpiSwiglu E{R1};
          pg8::gemm_phase<EpiSwiglu, pg8::StaticOrder, true, true>(lds, g, S, E);
#ifdef PROBE_GU2
          if (l == 0) pg8::gemm_phase<EpiSwiglu, pg8::StaticOrder, true, true>(lds, g, S, E);
#endif
          }
        xcd_barrier(bar);
        { pg8::Gemm g{R1, (const bf16*)(ws + (l ? WS_WD1 : WS_WD0)), M, 1024, FF}; pg8::StaticOrder S; S.init(M, 1024, G, (int)blockIdx.x);
          if (l == 0) { EpiResid<true, true> E{XR, XR, modl + 5 * 1024}; pg8::gemm_phase<EpiResid<true, true>, pg8::StaticOrder, true, true>(lds, g, S, E); }
          else { EpiResid<true, false> E{XR, p.out, modl + 5 * 1024}; pg8::gemm_phase<EpiResid<true, false>, pg8::StaticOrder, true, true>(lds, g, S, E); } }
        if (l == 0) xcd_barrier(bar);
}

__global__ void __launch_bounds__(NTHR, 2) fwd_kernel(Params p) {
    extern __shared__ __attribute__((aligned(16))) unsigned char lds_raw[];
    cg::grid_group grid = cg::this_grid();
    LAS unsigned char* lds = (LAS unsigned char*)lds_raw;
    const int tid = threadIdx.x, lane = tid & 63, wave = __builtin_amdgcn_readfirstlane(tid >> 6);
    const int G = gridDim.x, gw = blockIdx.x * NWAVES + wave, ngw = G * NWAVES;
    unsigned char* ws = p.ws;
    bf16* Watt = (bf16*)(ws + WS_WATT); bf16* Wao = (bf16*)(ws + WS_WAO); bf16* Wci = (bf16*)(ws + WS_WCI); bf16* Wco = (bf16*)(ws + WS_WCO);
    float* modv = (float*)(ws + WS_MOD);
    bf16* H = (bf16*)(ws + WS_H); bf16* R1 = (bf16*)(ws + WS_R1);
    bf16* Qb = (bf16*)(ws + WS_Q); bf16* QIb = (bf16*)(ws + WS_QI); bf16* Kb = (bf16*)(ws + WS_K); bf16* Vb = (bf16*)(ws + WS_V); bf16* KIb = (bf16*)(ws + WS_KI);
    float* WIb = (float*)(ws + WS_WI);

    if (tid < 4) ((LAS unsigned*)(lds + LDS_BARST))[tid] = 0u;
    __syncthreads();
    const XcdBarrier bar = xcd_barrier_post((unsigned*)(ws + WS_BAR), (volatile LAS unsigned*)(lds + LDS_BARST));
    if (blockIdx.x == 0 && tid < 32) ((float*)(ws + WS_INVF))[tid] = p.inv_freq[tid];
    if (blockIdx.x == 0 && tid == 32) { unsigned long long* pt = (unsigned long long*)(ws + WS_INVF + 256);
        pt[0] = (unsigned long long)p.pos; pt[1] = (unsigned long long)p.kg; pt[2] = (unsigned long long)p.lng; pt[3] = (unsigned long long)p.lnb; pt[4] = (unsigned long long)p.qg; }
#ifdef PROBE_P02
    for (int rep_ = 0; rep_ < 2; ++rep_) {
#else
    {
#endif
    if (blockIdx.x < 192) {
        const int l = blockIdx.x / 96, j0 = (blockIdx.x % 96) * 64;
        LAS float* cact = (LAS float*)(lds + 69632); LAS float* red = (LAS float*)(lds + 86016);
        for (int i = tid; i < 4096; i += NTHR) { const float cv = p.c[i]; cact[i] = cv / (1.f + __expf(-cv)); }
        __syncthreads();
        const int col = tid & 63, ks = tid >> 6;
        float a0 = 0.f, a1 = 0.f, a2 = 0.f, a3 = 0.f;
        const float* wp = p.ada_w + ((size_t)l * 1024 + ks * 128) * 6144 + j0 + col;
#pragma unroll 16
        for (int k = 0; k < 128; ++k) { const float w = wp[(size_t)k * 6144]; const int kk = ks * 128 + k;
            a0 += cact[kk] * w; a1 += cact[1024 + kk] * w; a2 += cact[2048 + kk] * w; a3 += cact[3072 + kk] * w; }
        red[(ks * 64 + col) * 4 + 0] = a0; red[(ks * 64 + col) * 4 + 1] = a1; red[(ks * 64 + col) * 4 + 2] = a2; red[(ks * 64 + col) * 4 + 3] = a3;
        __syncthreads();
        if (tid < 256) { const int c2 = tid & 63, b = tid >> 6; float s = p.ada_b[l * 6144 + j0 + c2];
#pragma unroll
            for (int k2 = 0; k2 < 8; ++k2) s += red[(k2 * 64 + c2) * 4 + b];
            modv[(size_t)(l * 4 + b) * 6144 + j0 + c2] = s; }
    }
    {
        LAS float* scr = (LAS float*)(lds + wave * 8448);
        constexpr int I_ATT = 16 * 72, I_AO = 16 * 32, I_G = 16 * 88, I_D = 44 * 32, I_CI = 16 * 96, I_CO = 16 * 32;
        constexpr int NITEMS = I_ATT + I_AO + 4 * I_G + 2 * I_D + I_CI + I_CO;
        for (int it = gw; it < NITEMS; it += ngw) {
            int r = it;
            if (r < I_ATT) { transpose_item(p.attn_w_in, 1024, NATT, 72, Watt, 4, scr, r, lane); continue; } r -= I_ATT;
            if (r < I_AO) { transpose_item(p.attn_w_out, 1024, 1024, 32, Wao, 0, scr, r, lane); continue; } r -= I_AO;
            if (r < 4 * I_G) { const int which = r / I_G, l = which >> 1, up = which & 1; r -= which * I_G;
                transpose_item((up ? p.wu : p.wg) + (size_t)l * 1024 * FF, 1024, FF, 88, (bf16*)(ws + (l ? WS_WGU1 : WS_WGU0)), 1 + up, scr, r, lane); continue; } r -= 4 * I_G;
            if (r < 2 * I_D) { const int l = r / I_D; r -= l * I_D;
                transpose_item(p.wd + (size_t)l * FF * 1024, FF, 1024, 32, (bf16*)(ws + (l ? WS_WD1 : WS_WD0)), 0, scr, r, lane); continue; } r -= 2 * I_D;
            if (r < I_CI) { transpose_item(p.conv_w_in, 1024, NCI, 96, Wci, 3, scr, r, lane); continue; } r -= I_CI;
            transpose_item(p.conv_w_out, 1024, 1024, 32, Wco, 0, scr, r, lane);
        }
    }
    }
    xcd_barrier(bar);

    run_layer<0>(p, lds, bar);
    run_layer<1>(p, lds, bar);
    if (p.ws == nullptr) grid.sync();
}

extern "C" void kernel_launch(void* const* d_in, const int* in_sizes, int n_in, void* d_out, int out_size, void* d_ws, size_t ws_size, hipStream_t stream) {
    static int grid = 0;
    if (grid == 0) {
        if (n_in != 19 || in_sizes[0] != M * D || out_size != M * D || ws_size < WS_END) { fprintf(stderr, "kernel_launch: unexpected shapes (n_in %d, in0 %d, out %d, ws %zu)\n", n_in, n_in > 0 ? in_sizes[0] : -1, out_size, ws_size); grid = -1; return; }
        int dev = 0, cus = 0, per_cu = 0;
        (void)hipGetDevice(&dev); (void)hipDeviceGetAttribute(&cus, hipDeviceAttributeMultiprocessorCount, dev);
        if (hipFuncSetAttribute((const void*)fwd_kernel, hipFuncAttributeMaxDynamicSharedMemorySize, LDS_BYTES) != hipSuccess) { fprintf(stderr, "kernel_launch: hipFuncSetAttribute failed\n"); grid = -1; return; }
        if (hipOccupancyMaxActiveBlocksPerMultiprocessor(&per_cu, (const void*)fwd_kernel, NTHR, LDS_BYTES) != hipSuccess || per_cu < 1) per_cu = 1;
        (void)hipGetLastError();
        grid = cus * per_cu;
        if (grid <= 0) grid = 256;
    }
    if (grid < 0) return;
    Params p{};
    p.x = (const float*)d_in[0]; p.c = (const float*)d_in[1]; p.pos = (const int*)d_in[2];
    p.ada_w = (const float*)d_in[3]; p.ada_b = (const float*)d_in[4]; p.n1g = (const float*)d_in[5]; p.n2g = (const float*)d_in[6];
    p.attn_w_in = (const float*)d_in[7]; p.qg = (const float*)d_in[8]; p.kg = (const float*)d_in[9]; p.lng = (const float*)d_in[10]; p.lnb = (const float*)d_in[11];
    p.attn_w_out = (const float*)d_in[12]; p.conv_w_in = (const float*)d_in[13]; p.conv_w = (const float*)d_in[14]; p.conv_w_out = (const float*)d_in[15];
    p.wg = (const float*)d_in[16]; p.wu = (const float*)d_in[17]; p.wd = (const float*)d_in[18];
    p.out = (float*)d_out; p.ws = (unsigned char*)d_ws;
    for (int i = 0; i < 32; ++i) p.inv_freq[i] = (float)pow(10000.0, -(double)i / 32.0);
    (void)hipMemsetAsync((unsigned char*)d_ws + WS_BAR, 0, 16384, stream);
    void* args[] = {&p};
    const hipError_t e = hipLaunchCooperativeKernel((const void*)fwd_kernel, dim3(grid), dim3(NTHR), args, LDS_BYTES, stream);
    if (e != hipSuccess) fprintf(stderr, "kernel_launch: cooperative launch failed: %s (grid %d)\n", hipGetErrorString(e), grid);
}
```

```cpp
#include <hip/hip_runtime.h>
#include <hip/hip_cooperative_groups.h>
#include <cstdio>
#include <cstdint>
#include <cmath>
namespace cg = cooperative_groups;
namespace pg8 {
#define PG8_LAS __attribute__((address_space(3)))
typedef unsigned short bf16_t;
typedef short bf16x8 __attribute__((ext_vector_type(8)));
typedef float f32x4 __attribute__((ext_vector_type(4)));
typedef unsigned u32x4 __attribute__((ext_vector_type(4)));
constexpr int BM = 256, BK = 64, HALF = 128, HTB = HALF * BK * 2  , STAGE_BYTES = 8 * HTB, NXCD = 8, WGM = 8;

__host__ __device__ __forceinline__ int lds_byte(int r, int c) { const int st = (r >> 4) * 2 + (c >> 5), rr = r & 15, cc = c & 31, ob = rr * 64 + cc * 2; return st * 1024 + (ob ^ (((ob >> 9) & 1) << 5)); }
__host__ __device__ __forceinline__ void stage_rc(int b, int& R, int& C) { const int st = b / 1024, sb = b % 1024, swz = sb ^ (((sb >> 9) & 1) << 5); R = (st >> 1) * 16 + swz / 64; C = (st & 1) * 32 + (swz % 64) / 2; }
__host__ __device__ __forceinline__ int perm32(int rho) { const int n = rho >> 4, i = rho & 15; return 8 * (i >> 2) + 4 * n + (i & 3); }

struct Unit { int pm, pn; };
struct Gemm { const bf16_t* A; const bf16_t* Bt; int M, N, K; };

struct StaticOrder {
    int nM, nN, nwg, G, c;
    __host__ __device__ void init(int M, int N, int G_, int c_) { nM = M / BM; nN = N / BM; nwg = nM * nN; G = G_; c = c_; }
    __host__ __device__ bool next(int i, Unit& u) const {
        const long L = (long)i * G + c; if (L >= nwg) return false;
        int wgid = (int)L; { const int q = nwg / NXCD, r = nwg % NXCD, xcd = wgid % NXCD, off = wgid / NXCD; wgid = (xcd < r ? xcd * (q + 1) : r * (q + 1) + (xcd - r) * q) + off; }
        const int nig = WGM * nN, gid = wgid / nig, fm = gid * WGM, gsz = (nM - fm) < WGM ? (nM - fm) : WGM;
        u.pm = fm + ((wgid % nig) % gsz); u.pn = (wgid % nig) / gsz; return true;
    }
    __device__ __forceinline__ void a_ready(const Unit&) const {}
    __device__ __forceinline__ void done(const Unit&) const {}
};

__device__ __forceinline__ unsigned cvt_pk_bf16(float lo, float hi) { unsigned r; asm volatile("v_cvt_pk_bf16_f32 %0, %1, %2" : "=v"(r) : "v"(lo), "v"(hi)); return r; }

template <class Epi, class Sched, bool ALIGN_EPI = false, bool SP2 = false>
__device__ __forceinline__ void gemm_phase(PG8_LAS unsigned char* lds, const Gemm g, const Sched& S, const Epi& E) {
    const int tid = threadIdx.x, wid = __builtin_amdgcn_readfirstlane(tid >> 6), lane = tid & 63, wr = wid >> 2, wc = wid & 3, fr = lane & 15, fq = lane >> 4;
    const int K = g.K, nt = K / BK;
    unsigned voffA[2], voffB[2];
#pragma unroll
    for (int i = 0; i < 2; ++i) { int R, C; stage_rc(tid * 16 + i * 8192, R, C); const int Rb = Epi::PERM ? ((R & ~31) + perm32(R & 31)) : R;
        voffA[i] = (unsigned)(R * K + C) * 2u; voffB[i] = (unsigned)(Rb * K + C) * 2u; }
    const size_t kstep = (size_t)(BK * 2);
    const size_t hstep = (size_t)HALF * K * 2;
    const size_t tstep = 2 * hstep;
    const unsigned ldsw = (unsigned)wid * 1024u;
    const int aoff = lds_byte(wr * 64 + fr, fq * 8), boff = lds_byte(wc * 32 + fr, fq * 8);
#define PG8_SA(b, h) (((b) * 2 + (h)) * HTB)
#define PG8_SB(b, h) ((4 + (b) * 2 + (h)) * HTB)
#define PG8_STAGE(bufoff, gbase, voff) do { _Pragma("unroll") for (int _i = 0; _i < 2; ++_i) \
        __builtin_amdgcn_global_load_lds((const unsigned*)((const char*)(gbase) + (voff)[_i]), (PG8_LAS unsigned*)(lds + (bufoff) + ldsw + _i * 8192), 16, 0, 0); } while (0)
#define PG8_LDA(dst, b, h) do { _Pragma("unroll") for (int m = 0; m < 4; ++m) _Pragma("unroll") for (int k = 0; k < 2; ++k) dst[m][k] = *(const PG8_LAS bf16x8*)(lds + PG8_SA(b, h) + aoff + m * 2048 + k * 1024); } while (0)
#define PG8_LDB(dst, b, h) do { _Pragma("unroll") for (int n = 0; n < 2; ++n) _Pragma("unroll") for (int k = 0; k < 2; ++k) dst[n][k] = *(const PG8_LAS bf16x8*)(lds + PG8_SB(b, h) + boff + n * 2048 + k * 1024); } while (0)
#define PG8_MMA(ai, bj, At, Bt) do { __builtin_amdgcn_s_setprio(1); _Pragma("unroll") for (int m = 0; m < 4; ++m) _Pragma("unroll") for (int n = 0; n < 2; ++n) _Pragma("unroll") for (int k = 0; k < 2; ++k) \
        acc[ai][bj][m][n] = __builtin_amdgcn_mfma_f32_16x16x32_bf16(Bt[n][k], At[m][k], acc[ai][bj][m][n], 0, 0, 0); __builtin_amdgcn_s_setprio(0); } while (0)
#define PG8_WAIT_V(n) asm volatile("s_waitcnt vmcnt(" #n ")" ::: "memory")
#define PG8_WAIT_L(n) asm volatile("s_waitcnt lgkmcnt(" #n ")" ::: "memory")
#define PG8_BAR __builtin_amdgcn_s_barrier()
#define PG8_SCHED __builtin_amdgcn_sched_barrier(0)
    Unit cur, nxt; int ui = 0;
    if (!S.next(0, cur)) return;
    f32x4 acc[2][2][4][2];
#pragma unroll
    for (int a = 0; a < 2; ++a)
#pragma unroll
        for (int b = 0; b < 2; ++b)
#pragma unroll
            for (int m = 0; m < 4; ++m)
#pragma unroll
                for (int n = 0; n < 2; ++n) acc[a][b][m][n] = (f32x4){0.f, 0.f, 0.f, 0.f};
    bf16x8 At[4][2], B0[2][2], B1[2][2];
    const char* cA = (const char*)g.A + (size_t)cur.pm * tstep; const char* cB = (const char*)g.Bt + (size_t)cur.pn * tstep;
    S.a_ready(cur);
    if constexpr (SP2) {
        PG8_STAGE(PG8_SB(0, 0), cB, voffB); PG8_STAGE(PG8_SB(0, 1), cB + hstep, voffB); PG8_STAGE(PG8_SA(0, 0), cA, voffA); PG8_STAGE(PG8_SA(0, 1), cA + hstep, voffA);
        if (wr == 1) PG8_BAR;
        PG8_WAIT_V(2); PG8_BAR;
        PG8_STAGE(PG8_SB(1, 0), cB + kstep, voffB); PG8_STAGE(PG8_SA(1, 0), cA + kstep, voffA); PG8_STAGE(PG8_SB(1, 1), cB + hstep + kstep, voffB);
        PG8_WAIT_V(6); PG8_BAR;
    } else {
        PG8_STAGE(PG8_SB(0, 0), cB, voffB); PG8_STAGE(PG8_SA(0, 0), cA, voffA); PG8_STAGE(PG8_SB(0, 1), cB + hstep, voffB); PG8_STAGE(PG8_SA(0, 1), cA + hstep, voffA);
        if (wr == 1) PG8_BAR;
        PG8_WAIT_V(4); PG8_BAR;
        PG8_STAGE(PG8_SB(1, 0), cB + kstep, voffB); PG8_STAGE(PG8_SA(1, 0), cA + kstep, voffA); PG8_STAGE(PG8_SB(1, 1), cB + hstep + kstep, voffB);
        PG8_WAIT_V(6); PG8_BAR;
    }
    for (;;) {
        const bool has_next = S.next(ui + 1, nxt);
        const char* nA = has_next ? (const char*)g.A + (size_t)nxt.pm * tstep : cA; const char* nB = has_next ? (const char*)g.Bt + (size_t)nxt.pn * tstep : cB;
        for (int t = 0; t < nt; t += 2) {
            const bool last = (t == nt - 2);
            const char* a1 = cA + (size_t)(t + 1) * kstep;
            const char* a2 = last ? nA : cA + (size_t)(t + 2) * kstep; const char* b2 = last ? nB : cB + (size_t)(t + 2) * kstep;
            const char* a3 = a2 + kstep; const char* b3 = b2 + kstep;
            if (last && has_next) S.a_ready(nxt);
            if constexpr (SP2) {
            PG8_LDB(B0, 0, 0); PG8_LDB(B1, 0, 1); PG8_SCHED; PG8_LDA(At, 0, 0); PG8_STAGE(PG8_SA(1, 1), a1 + hstep, voffA);
            PG8_WAIT_V(8); PG8_WAIT_L(0); PG8_BAR; PG8_MMA(0, 0, At, B0); PG8_MMA(0, 1, At, B1); PG8_BAR; PG8_SCHED;
            PG8_LDA(At, 0, 1); PG8_STAGE(PG8_SB(0, 0), b2, voffB); PG8_STAGE(PG8_SB(0, 1), b2 + hstep, voffB); PG8_STAGE(PG8_SA(0, 0), a2, voffA);
            PG8_WAIT_V(8); PG8_WAIT_L(0); PG8_BAR; PG8_MMA(1, 0, At, B0); PG8_MMA(1, 1, At, B1); PG8_BAR; PG8_SCHED;
            PG8_LDB(B0, 1, 0); PG8_LDB(B1, 1, 1); PG8_SCHED; PG8_LDA(At, 1, 0); PG8_STAGE(PG8_SA(0, 1), a2 + hstep, voffA);
            PG8_WAIT_V(8); PG8_WAIT_L(0); PG8_BAR; PG8_MMA(0, 0, At, B0); PG8_MMA(0, 1, At, B1); PG8_BAR; PG8_SCHED;
            PG8_LDA(At, 1, 1); PG8_STAGE(PG8_SB(1, 0), b3, voffB); PG8_STAGE(PG8_SB(1, 1), b3 + hstep, voffB); PG8_STAGE(PG8_SA(1, 0), a3, voffA);
            PG8_WAIT_V(8); PG8_WAIT_L(0); PG8_BAR; PG8_MMA(1, 0, At, B0); PG8_MMA(1, 1, At, B1); PG8_BAR; PG8_SCHED;
            } else {
            PG8_LDB(B0, 0, 0); PG8_SCHED; PG8_LDA(At, 0, 0); PG8_STAGE(PG8_SA(1, 1), a1 + hstep, voffA);
            PG8_WAIT_L(8); PG8_BAR; PG8_WAIT_L(0); PG8_MMA(0, 0, At, B0); PG8_BAR; PG8_SCHED;
            PG8_LDB(B1, 0, 1); PG8_STAGE(PG8_SB(0, 0), b2, voffB);
            PG8_BAR; PG8_WAIT_L(0); PG8_MMA(0, 1, At, B1); PG8_BAR;
            PG8_LDA(At, 0, 1); PG8_STAGE(PG8_SA(0, 0), a2, voffA);
            PG8_BAR; PG8_WAIT_L(0); PG8_MMA(1, 0, At, B0); PG8_BAR; PG8_SCHED;
            PG8_STAGE(PG8_SB(0, 1), b2 + hstep, voffB);
            PG8_WAIT_V(6); PG8_BAR; PG8_MMA(1, 1, At, B1); PG8_BAR;
            PG8_LDB(B0, 1, 0); PG8_SCHED; PG8_LDA(At, 1, 0); PG8_STAGE(PG8_SA(0, 1), a2 + hstep, voffA);
            PG8_WAIT_L(8); PG8_BAR; PG8_WAIT_L(0); PG8_MMA(0, 0, At, B0); PG8_BAR; PG8_SCHED;
            PG8_LDB(B1, 1, 1); PG8_STAGE(PG8_SB(1, 0), b3, voffB);
            PG8_BAR; PG8_WAIT_L(0); PG8_MMA(0, 1, At, B1); PG8_BAR;
            PG8_LDA(At, 1, 1); PG8_STAGE(PG8_SA(1, 0), a3, voffA);
            PG8_BAR; PG8_WAIT_L(0); PG8_MMA(1, 0, At, B0); PG8_BAR; PG8_SCHED;
            PG8_STAGE(PG8_SB(1, 1), b3 + hstep, voffB);
            PG8_WAIT_V(6); PG8_BAR; PG8_MMA(1, 1, At, B1); PG8_BAR;
            }
        }
        if constexpr (ALIGN_EPI) { if (wr == 0) PG8_BAR; }
        if constexpr (!Epi::AFTER_DRAIN) { E(acc, cur, wr, wc, fr, fq); S.done(cur); }
        if (!has_next) break;
#pragma unroll
        for (int a = 0; a < 2; ++a)
#pragma unroll
            for (int b = 0; b < 2; ++b)
#pragma unroll
                for (int m = 0; m < 4; ++m)
#pragma unroll
                    for (int n = 0; n < 2; ++n) acc[a][b][m][n] = (f32x4){0.f, 0.f, 0.f, 0.f};
        cur = nxt; cA = nA; cB = nB; ++ui;
        if constexpr (ALIGN_EPI) { if (wr == 1) PG8_BAR; }
    }
    PG8_WAIT_V(0);
    if constexpr (!ALIGN_EPI) { if (wr == 0) PG8_BAR; }
    PG8_BAR;
    if constexpr (Epi::AFTER_DRAIN) { E.fused(acc, cur, wr, wc, fr, fq, lds, wid, lane); S.done(cur); }
#undef PG8_SA
#undef PG8_SB
#undef PG8_STAGE
#undef PG8_LDA
#undef PG8_LDB
#undef PG8_MMA
#undef PG8_WAIT_V
#undef PG8_WAIT_L
#undef PG8_BAR
#undef PG8_SCHED
}
}

constexpr int NBATCH = 4, T = 8192, D = 1024, M = NBATCH * T;
constexpr int FF = 2816, NGU = 2 * FF;
constexpr int NATT = 2120, NATTP = 2304, NCI = 3072;
constexpr float EPS = 1e-6f;
constexpr int NWAVES = 8, NTHR = 512;
constexpr int LDS_BYTES = 155648, LDS_BARST = 155136;

#define GAS __attribute__((address_space(1)))
#define LAS __attribute__((address_space(3)))
typedef unsigned short bf16;
typedef unsigned v4u __attribute__((ext_vector_type(4)));
typedef unsigned v2u __attribute__((ext_vector_type(2)));
typedef float f32x4 __attribute__((ext_vector_type(4)));
typedef float f32x16 __attribute__((ext_vector_type(16)));
typedef short bf16x8 __attribute__((ext_vector_type(8)));
#define LDS_WAIT() asm volatile("s_waitcnt lgkmcnt(0)" ::: "memory")

constexpr size_t MiB = 1u << 20;
constexpr size_t WS_WATT = 0, WS_WAO = 5 * MiB, WS_WGU0 = 7 * MiB, WS_WGU1 = 18 * MiB, WS_WD0 = 29 * MiB, WS_WD1 = 35 * MiB,
                 WS_WCI = 41 * MiB, WS_WCO = 47 * MiB, WS_MOD = 49 * MiB, WS_INVF = 50 * MiB, WS_H = 64 * MiB, WS_R1 = 128 * MiB,
                 WS_Q = 320 * MiB, WS_QI = 384 * MiB, WS_K = 416 * MiB, WS_V = 432 * MiB,
                 WS_KI = 272 * MiB, WS_WI = 276 * MiB, WS_SEL = 277 * MiB  , WS_BAR = 60 * MiB, WS_XR = 448 * MiB  , WS_END = 512 * MiB;

#define XB_TMO      128
#define XB_XCNT(j)  (256  + 64 * (j))
#define XB_XSUB(j)  (1280 + 64 * (j))
#define XB_XGEN(j)  (2304 + 64 * (j))
#define XB_TOP      3328
#define XB_TOPGEN   3392
#define XCD_BAR_WORDS 3456
#define XB_SPIN_CAP (1u << 18)

__device__ __forceinline__ unsigned xb_ld(unsigned* p)              { return __hip_atomic_load(p, __ATOMIC_RELAXED, __HIP_MEMORY_SCOPE_AGENT); }
__device__ __forceinline__ unsigned xb_add(unsigned* p, unsigned v) { return __hip_atomic_fetch_add(p, v, __ATOMIC_RELAXED, __HIP_MEMORY_SCOPE_AGENT); }
__device__ __forceinline__ unsigned xb_xcc_id() { return (unsigned)__builtin_amdgcn_s_getreg((3 << 11) | 20) & 0xFu; }
#define XB_SPIN(cond, bar) do { unsigned _sp = 0; while (cond) { __builtin_amdgcn_s_sleep(1); \
    if ((++_sp & 255u) == 0u) { if (xb_ld(&(bar)[XB_TMO])) break; if (_sp > XB_SPIN_CAP) { atomicAdd(&(bar)[XB_TMO], 1u); break; } } } } while (0)

struct XcdBarrier {
    unsigned* bar; unsigned x;
    volatile LAS unsigned* st;
};

__device__ __forceinline__ XcdBarrier xcd_barrier_post(unsigned* bar, volatile LAS unsigned* st) {
    XcdBarrier b; b.bar = bar; b.x = xb_xcc_id(); b.st = st;
    if (threadIdx.x == 0) (void)xb_add(&bar[XB_XCNT(b.x)], 1u);
    return b;
}
__device__ __forceinline__ void xcd_barrier_complete(unsigned* bar, unsigned x, unsigned& nloc, unsigned& nx) {
    const unsigned G = gridDim.x * gridDim.y * gridDim.z;
    unsigned sum, cnt, mine, sp = 0u;
    for (;;) {
        sum = 0u; cnt = 0u; mine = 0u;
#pragma unroll
        for (unsigned j = 0; j < 16; ++j) { const unsigned c = xb_ld(&bar[XB_XCNT(j)]); sum += c; cnt += (c > 0u) ? 1u : 0u; mine = (j == x) ? c : mine; }
        if (sum == G) break;
        __builtin_amdgcn_s_sleep(1);
        if ((++sp & 255u) == 0u) { if (xb_ld(&bar[XB_TMO])) break; if (sp > XB_SPIN_CAP) { atomicAdd(&bar[XB_TMO], 1u); break; } }
    }
    nloc = mine > 0u ? mine : 1u; nx = cnt > 0u ? cnt : 1u;
}

__device__ __forceinline__ void xcd_barrier(const XcdBarrier& b) {
    asm volatile("s_waitcnt vmcnt(0)" ::: "memory");
    __syncthreads();
    if (threadIdx.x == 0) {
        unsigned* bar = b.bar;
        __builtin_amdgcn_s_waitcnt(0);
        unsigned nloc = b.st[0], nx = b.st[1];
        if (nloc == 0u) { xcd_barrier_complete(bar, b.x, nloc, nx); b.st[0] = nloc; b.st[1] = nx; }
        const unsigned old = xb_add(&bar[XB_XSUB(b.x)], 1u);
        const unsigned gen = old / nloc;
        if (old + 1u == (gen + 1u) * nloc) {
            __builtin_amdgcn_fence(__ATOMIC_RELEASE, "agent");
            asm volatile("s_waitcnt vmcnt(0)" ::: "memory");
            const unsigned og = xb_add(&bar[XB_TOP], 1u);
            const unsigned tg = og / nx;
            if (og + 1u == (tg + 1u) * nx) xb_add(&bar[XB_TOPGEN], 1u);
            else XB_SPIN(xb_ld(&bar[XB_TOPGEN]) == tg, bar);
            __builtin_amdgcn_fence(__ATOMIC_ACQUIRE, "agent");
            xb_add(&bar[XB_XGEN(b.x)], 1u);
            asm volatile("s_waitcnt vmcnt(0)" ::: "memory");
        } else {
            XB_SPIN(xb_ld(&bar[XB_XGEN(b.x)]) == gen, bar);
            __builtin_amdgcn_fence(__ATOMIC_ACQUIRE, "agent");
            asm volatile("s_waitcnt vmcnt(0)" ::: "memory");
        }
    }
    __syncthreads();
}


struct Params {
    const float* x; const float* c; const int* pos;
    const float* ada_w; const float* ada_b; const float* n1g; const float* n2g;
    const float* attn_w_in; const float* qg; const float* kg; const float* lng; const float* lnb; const float* attn_w_out;
    const float* conv_w_in; const float* conv_w; const float* conv_w_out;
    const float* wg; const float* wu; const float* wd;
    float* out; unsigned char* ws;
    float inv_freq[32];
};

__device__ __forceinline__ float bf2f(unsigned v) { return __builtin_bit_cast(float, v << 16); }
__device__ __forceinline__ unsigned f2bf(float f) { unsigned u = __builtin_bit_cast(unsigned, f); return (u + 0x7fffu + ((u >> 16) & 1u)) >> 16; }
__device__ __forceinline__ unsigned pk2(float lo, float hi) { return pg8::cvt_pk_bf16(lo, hi); }
__device__ __forceinline__ float wave_sum(float v) {
#pragma unroll
    for (int o = 1; o < 64; o <<= 1) v += __shfl_xor(v, o);
    return v;
}

__device__ __forceinline__ void sincos_ang(float ang, float& s, float& c);
struct EpiAttnIn {
    static constexpr bool PERM = true, AFTER_DRAIN = false;
    bf16* O; int ldc; unsigned char* ws;
    __device__ __forceinline__ void operator()(const pg8::f32x4 (&acc)[2][2][4][2], const pg8::Unit& u, int wr, int wc, int fr, int fq) const {
        const int row0 = u.pm * 256 + wr * 64 + fr;
        bf16* Kb = (bf16*)(ws + WS_K); bf16* Vb = (bf16*)(ws + WS_V); bf16* KIb = (bf16*)(ws + WS_KI); float* WIb = (float*)(ws + WS_WI);
        const float* invf = (const float*)(ws + WS_INVF);
        if (u.pn == 5) {
#pragma unroll
            for (int ai = 0; ai < 2; ++ai)
#pragma unroll
                for (int m = 0; m < 4; ++m) { bf16* rowp = Vb + (size_t)(row0 + ai * 128 + m * 16) * 256 + wc * 64 + 8 * fq;
#pragma unroll
                    for (int bj = 0; bj < 2; ++bj) { const pg8::f32x4 v0 = acc[ai][bj][m][0], v1 = acc[ai][bj][m][1];
                        v4u w; w.x = pk2(v0[0], v0[1]); w.y = pk2(v0[2], v0[3]); w.z = pk2(v1[0], v1[1]); w.w = pk2(v1[2], v1[3]);
                        *(v4u*)(rowp + bj * 32) = w; } }
            return;
        }
        if (u.pn == 8 && wc >= 2) return;
        if (u.pn == 8 && wc == 1) {
            if (fq == 0) {
#pragma unroll
                for (int ai = 0; ai < 2; ++ai)
#pragma unroll
                    for (int m = 0; m < 4; ++m) { float* wp = WIb + (size_t)(row0 + ai * 128 + m * 16) * 8;
                        *(f32x4*)wp = acc[ai][0][m][0] * 0.04419417382415922f; *(f32x4*)(wp + 4) = acc[ai][0][m][1] * 0.04419417382415922f; }
            }
            return;
        }
        if (u.pn == 6 || u.pn == 7) {
            float fq8[8];
#pragma unroll
            for (int e = 0; e < 8; ++e) fq8[e] = invf[8 * fq + e];
            const int* posq = (const int*)((const unsigned long long*)(ws + WS_INVF + 256))[0];
#pragma unroll
            for (int ai = 0; ai < 2; ++ai)
#pragma unroll
                for (int m = 0; m < 4; ++m) { const int row = row0 + ai * 128 + m * 16; const float posf = (float)posq[row]; float ol[8], oh[8];
#pragma unroll
                    for (int e = 0; e < 8; ++e) { const float xl = bf2f(f2bf(acc[ai][0][m][e >> 2][e & 3])), xh = bf2f(f2bf(acc[ai][1][m][e >> 2][e & 3])); float sn, cs; sincos_ang(posf * fq8[e], sn, cs);
                        ol[e] = xl * cs - xh * sn; oh[e] = xh * cs + xl * sn; }
                    v4u wl, wh; wl.x = pk2(ol[0], ol[1]); wl.y = pk2(ol[2], ol[3]); wl.z = pk2(ol[4], ol[5]); wl.w = pk2(ol[6], ol[7]);
                    wh.x = pk2(oh[0], oh[1]); wh.y = pk2(oh[2], oh[3]); wh.z = pk2(oh[4], oh[5]); wh.w = pk2(oh[6], oh[7]);
                    bf16* qp = O + (size_t)row * ldc + u.pn * 256 + wc * 64 + 8 * fq; *(v4u*)qp = wl; *(v4u*)(qp + 32) = wh; }
            return;
        }
        const bool isk = (u.pn <= 4), isq = (u.pn < 4);
        const unsigned long long* ptab = (const unsigned long long*)(ws + WS_INVF + 256);
        const int* pos = (const int*)ptab[0]; const float* kg = (const float*)ptab[1]; const float* lng = (const float*)ptab[2]; const float* lnb = (const float*)ptab[3]; const float* qg = (const float*)ptab[4];
        float fr8[8], gl[8], gh[8];
        { const float* gsel = (isq ? qg : (isk ? kg : lng)) + 8 * fq;
#pragma unroll
          for (int e = 0; e < 8; ++e) { fr8[e] = invf[8 * fq + e]; gl[e] = gsel[e]; gh[e] = gsel[32 + e]; } }
#pragma unroll
        for (int ai = 0; ai < 2; ++ai)
#pragma unroll
            for (int m = 0; m < 4; ++m) { const int row = row0 + ai * 128 + m * 16;
                float vl[8], vh[8];
#pragma unroll
                for (int e = 0; e < 8; ++e) { vl[e] = acc[ai][0][m][e >> 2][e & 3]; vh[e] = acc[ai][1][m][e >> 2][e & 3]; }
                float mu = 0.f;
                if (!isk) { float sm = 0.f;
#pragma unroll
                    for (int e = 0; e < 8; ++e) sm += vl[e] + vh[e];
                    sm += __shfl_xor(sm, 16); sm += __shfl_xor(sm, 32); mu = sm * (1.f / 64.f); }
                float ss = 0.f;
#pragma unroll
                for (int e = 0; e < 8; ++e) { vl[e] -= mu; vh[e] -= mu; ss += vl[e] * vl[e] + vh[e] * vh[e]; }
                ss += __shfl_xor(ss, 16); ss += __shfl_xor(ss, 32);
                const float rs = rsqrtf(ss * (1.f / 64.f) + EPS) * (isq ? 0.125f * 1.4426950408889634f : 1.f)    , posf = (float)pos[row];
                float ol[8], oh[8];
                const float* lbp = lnb + 8 * fq; asm volatile("" : "+v"(lbp));
#pragma unroll
                for (int e = 0; e < 8; ++e) { const float yl = vl[e] * rs * gl[e] + (isk ? 0.f : lbp[e]), yh = vh[e] * rs * gh[e] + (isk ? 0.f : lbp[32 + e]); float sn, cs; sincos_ang(posf * fr8[e], sn, cs);
                    ol[e] = yl * cs - yh * sn; oh[e] = yh * cs + yl * sn; }
                v4u wl, wh; wl.x = pk2(ol[0], ol[1]); wl.y = pk2(ol[2], ol[3]); wl.z = pk2(ol[4], ol[5]); wl.w = pk2(ol[6], ol[7]);
                wh.x = pk2(oh[0], oh[1]); wh.y = pk2(oh[2], oh[3]); wh.z = pk2(oh[4], oh[5]); wh.w = pk2(oh[6], oh[7]);
                if (isq) { bf16* qp = O + (size_t)row * ldc + u.pn * 256 + wc * 64 + 8 * fq; *(v4u*)qp = wl; *(v4u*)(qp + 32) = wh; }
                else if (isk) { bf16* kp = Kb + (size_t)row * 256 + wc * 64 + 8 * fq; *(v4u*)kp = wl; *(v4u*)(kp + 32) = wh; }
                else { const int sq = row & (T - 1);
                    bf16* kp = KIb + (size_t)(row - sq) * 64 + (sq >> 5) * 2048 + (sq & 31) * 8;
                    const int dl = 8 * fq, dh = 32 + 8 * fq;
                    *(v4u*)(kp + (dl >> 4) * 512 + ((dl >> 3) & 1) * 256) = wl; *(v4u*)(kp + (dh >> 4) * 512 + ((dh >> 3) & 1) * 256) = wh; }
            }
    }
};
struct EpiStore {
    static constexpr bool PERM = true, AFTER_DRAIN = false;
    bf16* O; int ldc;
    __device__ __forceinline__ void operator()(const pg8::f32x4 (&acc)[2][2][4][2], const pg8::Unit& u, int wr, int wc, int fr, int fq) const {
        const int row0 = u.pm * 256 + wr * 64 + fr, col0 = u.pn * 256 + wc * 32 + 8 * fq;
#pragma unroll
        for (int ai = 0; ai < 2; ++ai)
#pragma unroll
            for (int m = 0; m < 4; ++m) { bf16* rowp = O + (size_t)(row0 + ai * 128 + m * 16) * ldc + col0;
#pragma unroll
                for (int bj = 0; bj < 2; ++bj) { const pg8::f32x4 v0 = acc[ai][bj][m][0], v1 = acc[ai][bj][m][1];
                    v4u w; w.x = pk2(v0[0], v0[1]); w.y = pk2(v0[2], v0[3]); w.z = pk2(v1[0], v1[1]); w.w = pk2(v1[2], v1[3]);
                    *(v4u*)(rowp + bj * 128) = w; } }
    }
};
template <bool XIN_BF16, bool OUT_BF16> struct EpiResid {
    static constexpr bool PERM = true, AFTER_DRAIN = false;
    const void* xin; void* out; const float* gate;
    __device__ __forceinline__ void operator()(const pg8::f32x4 (&acc)[2][2][4][2], const pg8::Unit& u, int wr, int wc, int fr, int fq) const {
        const int row0 = u.pm * 256 + wr * 64 + fr, col0 = u.pn * 256 + wc * 32 + 8 * fq;
        const float* gp = gate + (size_t)((u.pm * 256) >> 13) * 6144 + col0;
        f32x4 gv[2][2];
#pragma unroll
        for (int bj = 0; bj < 2; ++bj)
#pragma unroll
            for (int n = 0; n < 2; ++n) gv[bj][n] = *(const f32x4*)(gp + bj * 128 + 4 * n);
#pragma unroll
        for (int ai = 0; ai < 2; ++ai)
#pragma unroll
            for (int m = 0; m < 4; ++m) { const size_t rb = (size_t)(row0 + ai * 128 + m * 16) * D + col0;
#pragma unroll
                for (int bj = 0; bj < 2; ++bj) { f32x4 x0, x1;
                    if (XIN_BF16) { const v4u w = *(const v4u*)((const bf16*)xin + rb + bj * 128);
                        x0 = (f32x4){bf2f(w.x & 0xffffu), bf2f(w.x >> 16), bf2f(w.y & 0xffffu), bf2f(w.y >> 16)}; x1 = (f32x4){bf2f(w.z & 0xffffu), bf2f(w.z >> 16), bf2f(w.w & 0xffffu), bf2f(w.w >> 16)}; }
                    else { x0 = *(const f32x4*)((const float*)xin + rb + bj * 128); x1 = *(const f32x4*)((const float*)xin + rb + bj * 128 + 4); }
                    const f32x4 o0 = x0 + gv[bj][0] * acc[ai][bj][m][0], o1 = x1 + gv[bj][1] * acc[ai][bj][m][1];
                    if (OUT_BF16) { v4u w; w.x = pk2(o0.x, o0.y); w.y = pk2(o0.z, o0.w); w.z = pk2(o1.x, o1.y); w.w = pk2(o1.z, o1.w); *(v4u*)((bf16*)out + rb + bj * 128) = w; }
                    else { *(f32x4*)((float*)out + rb + bj * 128) = o0; *(f32x4*)((float*)out + rb + bj * 128 + 4) = o1; } } }
    }
};
struct EpiConvIn {
    static constexpr bool PERM = true, AFTER_DRAIN = false;
    bf16* Z; bf16* Bg;
    __device__ __forceinline__ void operator()(const pg8::f32x4 (&acc)[2][2][4][2], const pg8::Unit& u, int wr, int wc, int fr, int fq) const {
        const int row0 = u.pm * 256 + wr * 64 + fr;
        if (u.pn < 8) {
            const int ch0 = u.pn * 128 + wc * 32 + 8 * fq;
#pragma unroll
            for (int ai = 0; ai < 2; ++ai)
#pragma unroll
                for (int m = 0; m < 4; ++m) { bf16* rowp = Z + (size_t)(row0 + ai * 128 + m * 16) * D + ch0;
                    const pg8::f32x4 z0 = acc[ai][0][m][0] * acc[ai][1][m][0], z1 = acc[ai][0][m][1] * acc[ai][1][m][1];
                    v4u w; w.x = pk2(z0[0], z0[1]); w.y = pk2(z0[2], z0[3]); w.z = pk2(z1[0], z1[1]); w.w = pk2(z1[2], z1[3]); *(v4u*)rowp = w; }
        } else {
            const int col0 = (u.pn - 8) * 256 + wc * 32 + 8 * fq;
#pragma unroll
            for (int ai = 0; ai < 2; ++ai)
#pragma unroll
                for (int m = 0; m < 4; ++m) { bf16* rowp = Bg + (size_t)(row0 + ai * 128 + m * 16) * D + col0;
#pragma unroll
                    for (int bj = 0; bj < 2; ++bj) { const pg8::f32x4 v0 = acc[ai][bj][m][0], v1 = acc[ai][bj][m][1];
                        v4u w; w.x = pk2(v0[0], v0[1]); w.y = pk2(v0[2], v0[3]); w.z = pk2(v1[0], v1[1]); w.w = pk2(v1[2], v1[3]);
                        *(v4u*)(rowp + bj * 128) = w; } }
        }
    }
};
struct EpiSwiglu {
    static constexpr bool PERM = true, AFTER_DRAIN = false;
    bf16* ACT;
    __device__ __forceinline__ void operator()(const pg8::f32x4 (&acc)[2][2][4][2], const pg8::Unit& u, int wr, int wc, int fr, int fq) const {
        const int row0 = u.pm * 256 + wr * 64 + fr, hid0 = u.pn * 128 + wc * 32 + 8 * fq;
#pragma unroll
        for (int ai = 0; ai < 2; ++ai)
#pragma unroll
            for (int m = 0; m < 4; ++m) { bf16* rowp = ACT + (size_t)(row0 + ai * 128 + m * 16) * FF + hid0; float r[8];
#pragma unroll
                for (int n = 0; n < 2; ++n) { const pg8::f32x4 g = acc[ai][0][m][n], uu = acc[ai][1][m][n];
#pragma unroll
                    for (int e = 0; e < 4; ++e) r[4 * n + e] = g[e] * __builtin_amdgcn_rcpf(1.f + __expf(-g[e])) * uu[e]; }
                v4u w; w.x = pk2(r[0], r[1]); w.y = pk2(r[2], r[3]); w.z = pk2(r[4], r[5]); w.w = pk2(r[6], r[7]);
                *(v4u*)rowp = w; }
    }
};

__device__ __forceinline__ void transpose_item(const float* W, int K, int N, int nblk, bf16* WT, int mode, LAS float* scr, int item, int lane) {
    const int kb = item / nblk, nb = item % nblk, k0 = 64 * kb, n0 = 32 * nb;
    const int ncol = n0 + (lane & 31);
#pragma unroll
    for (int i = 0; i < 32; ++i) { const int kk = 2 * i + (lane >> 5); scr[kk * 33 + (lane & 31)] = (ncol < N) ? W[(size_t)(k0 + kk) * N + ncol] : 0.f; }
    LDS_WAIT();
    const int c = lane & 7;
#pragma unroll
    for (int j = 0; j < 4; ++j) { const int nl = (lane >> 3) + 8 * j, n = n0 + nl; const LAS float* s = scr + (8 * c) * 33 + nl;
        v4u o; o.x = pk2(s[0 * 33], s[1 * 33]); o.y = pk2(s[2 * 33], s[3 * 33]); o.z = pk2(s[4 * 33], s[5 * 33]); o.w = pk2(s[6 * 33], s[7 * 33]);
        int dest;
        if (mode == 0) dest = n;
        else if (mode == 4) { const int tile = n >> 8, o = n & 255; dest = tile * 256 + 128 * ((o >> 5) & 1) + 32 * (o >> 6) + (o & 31); (void)n; }
        else if (mode == 3) { const int j = n & 1023; dest = (n < 1024) ? 2048 + n : (256 * (j >> 7) + (j & 127) + (n >= 2048 ? 128 : 0)); }
        else dest = 256 * (n >> 7) + (n & 127) + (mode == 2 ? 128 : 0);
        *(v4u*)(WT + (size_t)dest * K + k0 + 8 * c) = o; }
    LDS_WAIT();
}

template <bool IN_BF16>
__device__ __forceinline__ void norm_rows(const void* xin, bf16* H, const float* g, const float* modl, int shift_idx, int tid_in) {
    int tid = tid_in; asm volatile("" : "+v"(tid));
    const int lane = tid & 63, gw = blockIdx.x * NWAVES + __builtin_amdgcn_readfirstlane(tid >> 6), ngw = gridDim.x * NWAVES;
    f32x4 vn[4];
#define NR_LOAD(mrow) { _Pragma("unroll") for (int j_ = 0; j_ < 4; ++j_) { \
        if (IN_BF16) { const v2u w_ = ((const v2u*)((const bf16*)xin + (size_t)(mrow) * D) + lane)[64 * j_]; vn[j_] = (f32x4){bf2f(w_.x & 0xffffu), bf2f(w_.x >> 16), bf2f(w_.y & 0xffffu), bf2f(w_.y >> 16)}; } \
        else vn[j_] = ((const f32x4*)((const float*)xin + (size_t)(mrow) * D) + lane)[64 * j_]; } }
    if (gw < M) NR_LOAD(gw)
    for (int m = gw; m < M; m += ngw) {
        const float* sh = modl + (size_t)(m >> 13) * 6144 + shift_idx * 1024; const float* sc = sh + 1024;
        f32x4 v[4]; float ss = 0.f;
#pragma unroll
        for (int j = 0; j < 4; ++j) { v[j] = vn[j]; ss += (v[j].x * v[j].x + v[j].y * v[j].y) + (v[j].z * v[j].z + v[j].w * v[j].w); }
        { const int mn = (m + ngw < M) ? m + ngw : m; NR_LOAD(mn) }
        const float rstd = rsqrtf(wave_sum(ss) * (1.f / D) + EPS);
        v2u* o8 = (v2u*)(H + (size_t)m * D) + lane;
#pragma unroll
        for (int j = 0; j < 4; ++j) { const int col = 4 * lane + 256 * j;
            const f32x4 gg = *(const f32x4*)(g + col), scv = *(const f32x4*)(sc + col), shv = *(const f32x4*)(sh + col);
            const f32x4 y = v[j] * rstd * gg * (scv + 1.f) + shv;
            v2u w; w.x = pk2(y.x, y.y); w.y = pk2(y.z, y.w); o8[64 * j] = w; }
    }
#undef NR_LOAD
}

__device__ __forceinline__ void sincos_ang(float ang, float& s, float& c) {
    double r = (double)ang * 0.15915494309189535; r -= __builtin_rint(r);
    const float rf = (float)r; s = __builtin_amdgcn_sinf(rf); c = __builtin_amdgcn_cosf(rf);
}
__device__ __forceinline__ unsigned fkey(float f) { const unsigned u = __builtin_bit_cast(unsigned, f); return (u & 0x80000000u) ? ~u : (u | 0x80000000u); }

#ifdef PROBE_ATOM2
#define PROBE_ATOM_EXTRA { LAS unsigned* dq_ = (LAS unsigned*)(lds + 155648) + hf * 1024; lds_add(dq_ + (b0_ >> 1), 1u); lds_add(dq_ + (b1_ >> 1), 1u); }
#else
#define PROBE_ATOM_EXTRA
#endif
constexpr int S_KEYS = 0, S_HIST = 131072, S_SEL = 147456, S_TIE = 149504, S_ST = 153600;
__device__ __forceinline__ unsigned lds_add(LAS unsigned* p, unsigned v) { return __hip_atomic_fetch_add(p, v, __ATOMIC_RELAXED, __HIP_MEMORY_SCOPE_WORKGROUP); }

template <int PASS>
__device__ __forceinline__ void radix_pass(LAS unsigned char* lds, int tid, int wave, int lane, int nchunk  ) {
    constexpr int SHIFT = PASS == 0 ? 21 : (PASS == 1 ? 10 : 0);
    constexpr int BITS = PASS == 2 ? 10 : 11, NBIN = 1 << BITS, PER = NBIN / 64, HISHIFT = (SHIFT + BITS) & 31;
    LAS unsigned* hist = (LAS unsigned*)(lds + S_HIST);
    LAS unsigned* st = (LAS unsigned*)(lds + S_ST);
    if (PASS != 0) { for (int i = tid; i < 1024; i += NTHR) ((LAS v4u*)hist)[i] = (v4u){0u, 0u, 0u, 0u}; }
    __syncthreads();
    if (PASS != 0) {
        const int q = wave >> 1; const unsigned pf = st[q * 8];
        LAS unsigned* hq = hist + q * 1024;
        const LAS v4u* kq = (const LAS v4u*)(lds + S_KEYS + q * 32768);
        for (int c = (wave & 1) * 64 + lane; c < nchunk; c += 128) {
            const v4u k = kq[c];
#pragma unroll
            for (int e = 0; e < 4; ++e) { const unsigned key = k[e];
                if (PASS == 0 ? (key != 0u) : ((key >> HISHIFT) == pf)) { const unsigned bin = (key >> SHIFT) & (NBIN - 1); lds_add(hq + (bin >> 1), 1u << (16 * (bin & 1))); } }
        }
    }
    __syncthreads();
    if (wave < 4) {
        const int q = wave; const unsigned need = st[q * 8 + 1];
        const LAS unsigned* hw = hist + q * 1024 + lane * (PER / 2);
        unsigned s = 0;
#pragma unroll
        for (int e = 0; e < PER / 2; ++e) { const unsigned w = hw[e]; s += (w & 0xffffu) + (w >> 16); }
        unsigned incl = s;
#pragma unroll
        for (int d = 1; d < 64; d <<= 1) { const unsigned o = __shfl_down(incl, d); if (lane + d < 64) incl += o; }
        const unsigned above = incl - s;
        if (PASS == 0) {
            const bool own = above < need && need <= incl;
            const unsigned long long bm = __ballot(own); const int ol = bm ? (int)__builtin_ctzll(bm) : 0;
            const unsigned above_o = (unsigned)__shfl((int)above, ol);
            unsigned hb = 0u;
            if (lane < 32) { const unsigned w = hist[q * 1024 + ol * 16 + (lane >> 1)]; hb = (lane & 1) ? (w >> 16) : (w & 0xffffu); }
            unsigned incl2 = hb;
#pragma unroll
            for (int d = 1; d < 32; d <<= 1) { const unsigned o = __shfl_down(incl2, d); if (lane + d < 32) incl2 += o; }
            const unsigned above2 = above_o + incl2 - hb;
            if (lane < 32 && above2 < need && need <= above2 + hb) { st[q * 8 + 0] = (unsigned)(ol * 32 + lane); st[q * 8 + 1] = need - above2; st[q * 8 + 4] = hb; }
        } else
        if (above < need && need <= incl) {
            unsigned cum = above; int bin = PER - 1; unsigned h = 0;
#pragma unroll 1
            for (;; --bin) { const unsigned w = hw[bin >> 1]; h = (bin & 1) ? (w >> 16) : (w & 0xffffu); if (cum + h >= need || bin == 0) break; cum += h; }
            st[q * 8 + 0] = (PASS == 0 ? 0u : (st[q * 8 + 0] << BITS)) | (unsigned)(lane * PER + bin);
            st[q * 8 + 1] = need - cum;
            st[q * 8 + 4] = h;
        }
    }
    __syncthreads();
}

__device__ __forceinline__ void select_phase(const Params& p, LAS unsigned char* lds, const bf16* PROJ, const bf16* KIb, const float* WIb, unsigned short* SEL, int tid_in) {
    const int G = gridDim.x, cid = blockIdx.x;
    LAS unsigned* st = (LAS unsigned*)(lds + S_ST);
    LAS unsigned short* sel = (LAS unsigned short*)(lds + S_SEL);
    LAS unsigned short* tie = (LAS unsigned short*)(lds + S_TIE);
#define UNIT_DECODE(round_, ok_, b_, t0_) { int ul_; \
    if ((G & 7) == 0) { const int x_ = cid & 7, nl_ = G >> 2, lw_ = (x_ & 1) * (G >> 3) + (cid >> 3); \
        b_ = x_ >> 1; ul_ = (round_) * nl_ + (((round_) & 1) ? (nl_ - 1 - lw_) : lw_); ok_ = ul_ < 1984; } \
    else { const int u_ = (round_) * G + (((round_) & 1) ? (G - 1 - cid) : cid); ok_ = u_ < 4 * 1984; b_ = u_ / 1984; ul_ = u_ % 1984; } \
    t0_ = ul_ * 4 + 256; }
#define AFR_LOAD(b_, t0_) { const size_t mb_ = (size_t)(b_) * T + (t0_); const int r_ = lane & 31, hf_ = lane >> 5; \
    { const int ii = r_ >> 3, hh = (r_ >> 2) & 1, jj = r_ & 3; const int q = 2 * hh + (ii >> 1), h = 4 * (ii & 1) + jj; \
      const bf16* qp = PROJ + (mb_ + q) * NATTP + 1536 + h * 64 + 8 * hf_;     \
      _Pragma("unroll") for (int ks = 0; ks < 4; ++ks) Afr[ks] = *(const bf16x8*)(qp + 16 * ks); afr_pos = p.pos[mb_ + q]; } \
    _Pragma("unroll") for (int ql = 0; ql < 2; ++ql) { const f32x4 a = *(const f32x4*)(WIb + (mb_ + 2 * hf_ + ql) * 8), c = *(const f32x4*)(WIb + (mb_ + 2 * hf_ + ql) * 8 + 4); \
        wq[ql][0] = a.x; wq[ql][1] = a.y; wq[ql][2] = a.z; wq[ql][3] = a.w; wq[ql][4] = c.x; wq[ql][5] = c.y; wq[ql][6] = c.z; wq[ql][7] = c.w; } }
    bf16x8 Afr[4]; float wq[2][8]; int afr_pos = 0;
#define AFR_ROPE() { const float posf_ = (float)afr_pos; const int hf_ = lane >> 5; \
    _Pragma("unroll") for (int ks = 0; ks < 2; ++ks) { const v4u lo_ = __builtin_bit_cast(v4u, Afr[ks]), hi_ = __builtin_bit_cast(v4u, Afr[ks + 2]); v4u ol_, oh_; \
        _Pragma("unroll") for (int w_ = 0; w_ < 4; ++w_) { const unsigned lw_ = lo_[w_], hw_ = hi_[w_]; float ro_[2][2]; \
            _Pragma("unroll") for (int z_ = 0; z_ < 2; ++z_) { const float xl_ = z_ ? bf2f(lw_ >> 16) : bf2f(lw_ & 0xffffu), xh_ = z_ ? bf2f(hw_ >> 16) : bf2f(hw_ & 0xffffu); \
                float sn_, cs_; sincos_ang(posf_ * p.inv_freq[16 * ks + 8 * hf_ + 2 * w_ + z_], sn_, cs_); ro_[0][z_] = xl_ * cs_ - xh_ * sn_; ro_[1][z_] = xh_ * cs_ + xl_ * sn_; } \
            ol_[w_] = pk2(ro_[0][0], ro_[0][1]); oh_[w_] = pk2(ro_[1][0], ro_[1][1]); } \
        Afr[ks] = __builtin_bit_cast(bf16x8, ol_); Afr[ks + 2] = __builtin_bit_cast(bf16x8, oh_); } }
    bool ok_n; int b_n, t0_n;
    UNIT_DECODE(0, ok_n, b_n, t0_n)
    { int tid = tid_in; asm volatile("" : "+v"(tid)); const int lane = tid & 63; if (ok_n) AFR_LOAD(b_n, t0_n) }
    for (int round = 0;; ++round) {
        int tid = tid_in; asm volatile("" : "+v"(tid));
        const int lane = tid & 63, wave = __builtin_amdgcn_readfirstlane(tid >> 6);
        if (!ok_n) break;
        const int b = b_n, t0 = t0_n; const size_t mbase = (size_t)b * T + t0;
        const int ntiles = ((t0 + 3) >> 5) + 1, nround = (ntiles + 31) & ~31;
        for (int i = tid; i < 1024; i += NTHR) ((LAS v4u*)(lds + S_HIST))[i] = (v4u){0u, 0u, 0u, 0u};
        if (tid < 4) { st[tid * 8 + 0] = 0u; st[tid * 8 + 1] = 256u; st[tid * 8 + 2] = 0u; st[tid * 8 + 3] = 0u; st[tid * 8 + 5] = 0u; st[tid * 8 + 6] = 0u; }
        __syncthreads();
#ifdef PROBE_IDX2
        for (int rep_ = 0; rep_ < 2; ++rep_)
#endif
        {
            const int r = lane & 31, hf = lane >> 5;
            const int tA = t0 + 2 * hf;
            const bf16* kbase = KIb + (size_t)b * T * 64 + lane * 8;
            LAS unsigned* kw0 = (LAS unsigned*)(lds + S_KEYS + (2 * hf) * 32768) + r; LAS unsigned* kw1 = kw0 + 8192;
            LAS unsigned* hq0 = (LAS unsigned*)(lds + S_HIST) + (2 * hf) * 1024; LAS unsigned* hdum = (LAS unsigned*)(lds + S_ST + 128) + lane;
            bf16x8 R0[4], R1[4], R2[4], R3[4];
#define IDX_LOAD(R, ktv) { const int ktc_ = (ktv) < ntiles ? (ktv) : (ntiles - 1); const bf16* kp_ = kbase + (size_t)ktc_ * 2048; \
    R[0] = *(const bf16x8*)(kp_); R[1] = *(const bf16x8*)(kp_ + 512); R[2] = *(const bf16x8*)(kp_ + 1024); R[3] = *(const bf16x8*)(kp_ + 1536); }
#define IDX_MMA(ACC, R, ktv) if ((ktv) < ntiles) { _Pragma("unroll") for (int e_ = 0; e_ < 16; ++e_) ACC[e_] = 0.f; \
    ACC = __builtin_amdgcn_mfma_f32_32x32x16_bf16(Afr[0], R[0], ACC, 0, 0, 0); ACC = __builtin_amdgcn_mfma_f32_32x32x16_bf16(Afr[1], R[1], ACC, 0, 0, 0); \
    ACC = __builtin_amdgcn_mfma_f32_32x32x16_bf16(Afr[2], R[2], ACC, 0, 0, 0); ACC = __builtin_amdgcn_mfma_f32_32x32x16_bf16(Afr[3], R[3], ACC, 0, 0, 0); }
#define IDX_POST(ACC, ktv) if ((ktv) >= 0 && (ktv) < ntiles) { float s0_ = 0.f, s1_ = 0.f; \
    _Pragma("unroll") for (int i4_ = 0; i4_ < 4; ++i4_) _Pragma("unroll") for (int j_ = 0; j_ < 4; ++j_) { const float a_ = ACC[4 * i4_ + j_]; const int vi_ = __float_as_int(a_); const float v_ = __int_as_float(vi_ > 0 ? vi_ : 0); const int h_ = 4 * (i4_ & 1) + j_; \
        if (i4_ >> 1) s1_ = __builtin_fmaf(wq[1][h_], v_, s1_); else s0_ = __builtin_fmaf(wq[0][h_], v_, s0_); } \
    const int s_ = 32 * (ktv) + r; const unsigned k0_ = (s_ <= tA) ? fkey(s0_) : 0u, k1_ = (s_ <= tA + 1) ? fkey(s1_) : 0u; kw0[32 * (ktv)] = k0_; kw1[32 * (ktv)] = k1_; \
    { const unsigned b0_ = k0_ >> 21, b1_ = k1_ >> 21; \
      lds_add(k0_ ? hq0 + (b0_ >> 1) : hdum, k0_ ? (1u << (16 * (b0_ & 1))) : 0u); lds_add(k1_ ? hq0 + 1024 + (b1_ >> 1) : hdum, k1_ ? (1u << (16 * (b1_ & 1))) : 0u); } }
            f32x16 accA, accB;
#pragma unroll
            for (int e = 0; e < 16; ++e) { accA[e] = 0.f; accB[e] = 0.f; }
            __builtin_amdgcn_sched_barrier(0); IDX_LOAD(R0, wave) __builtin_amdgcn_sched_barrier(0); IDX_LOAD(R1, wave + 8) __builtin_amdgcn_sched_barrier(0); IDX_LOAD(R2, wave + 16) __builtin_amdgcn_sched_barrier(0);
            int kt = wave;
            for (; kt < nround; kt += 32) {
                IDX_LOAD(R3, kt + 24) __builtin_amdgcn_sched_barrier(0); IDX_MMA(accA, R0, kt) IDX_POST(accB, kt - 8) __builtin_amdgcn_sched_barrier(0);
                IDX_LOAD(R0, kt + 32) __builtin_amdgcn_sched_barrier(0); IDX_MMA(accB, R1, kt + 8) IDX_POST(accA, kt) __builtin_amdgcn_sched_barrier(0);
                IDX_LOAD(R1, kt + 40) __builtin_amdgcn_sched_barrier(0); IDX_MMA(accA, R2, kt + 16) IDX_POST(accB, kt + 8) __builtin_amdgcn_sched_barrier(0);
                IDX_LOAD(R2, kt + 48) __builtin_amdgcn_sched_barrier(0); IDX_MMA(accB, R3, kt + 24) IDX_POST(accA, kt + 16) __builtin_amdgcn_sched_barrier(0);
            }
            IDX_POST(accB, kt - 8)
#undef IDX_MMA
#undef IDX_POST
#undef IDX_LOAD
        }
        UNIT_DECODE(round + 1, ok_n, b_n, t0_n)
        if (ok_n) AFR_LOAD(b_n, t0_n)
        const int nchunk = ntiles * 8;
        radix_pass<0>(lds, tid, wave, lane, nchunk);
#ifdef PROBE_RAD2
        if (tid < 4) { st[tid * 8 + 0] = 0u; st[tid * 8 + 1] = 256u; }
        radix_pass<0>(lds, tid, wave, lane, nchunk);
#endif
        LAS unsigned* ckey = (LAS unsigned*)(lds + S_HIST); LAS unsigned short* cidx = (LAS unsigned short*)(lds + S_HIST + 8192); LAS unsigned* shist = (LAS unsigned*)(lds + S_HIST + 12288);
        {
            const int q = wave >> 1; const unsigned Bq = st[q * 8];
            const LAS v4u* kq = (const LAS v4u*)(lds + S_KEYS + q * 32768);
            unsigned cnt = 0u;
            for (int c = (wave & 1) * 64 + lane; c < nchunk; c += 128) {
                const v4u k = kq[c];
#pragma unroll
                for (int e = 0; e < 4; ++e) { const unsigned bin = k[e] >> 21; cnt += (bin > Bq ? 1u : 0u) + (bin == Bq ? 0x10000u : 0u); }
            }
            unsigned incl = cnt;
#pragma unroll
            for (int d = 1; d < 64; d <<= 1) { const unsigned o = __shfl_up(incl, d); if (lane >= d) incl += o; }
            const unsigned excl = incl - cnt, tot = (unsigned)__shfl((int)incl, 63);
            unsigned baseA = 0u, baseC = 0u;
            if (lane == 0) { baseA = lds_add(&st[q * 8 + 2], tot & 0xffffu); baseC = lds_add(&st[q * 8 + 5], tot >> 16); }
            baseA = (unsigned)__shfl((int)baseA, 0); baseC = (unsigned)__shfl((int)baseC, 0);
            unsigned pa = baseA + (excl & 0xffffu), pc = baseC + (excl >> 16);
            for (int c = (wave & 1) * 64 + lane; c < nchunk; c += 128) {
                const v4u k = kq[c];
#pragma unroll
                for (int e = 0; e < 4; ++e) { const unsigned key = k[e]; const unsigned bin = key >> 21; const unsigned short s = (unsigned short)(4 * c + e);
                    if (bin > Bq) { sel[q * 256 + (pa & 255u)] = s; ++pa; }
                    else if (bin == Bq) { if (pc < 512u) { ckey[q * 512 + pc] = key; cidx[q * 512 + pc] = s; } ++pc; } }
            }
        }
        __syncthreads();
        const bool small = st[4] <= 512u && st[12] <= 512u && st[20] <= 512u && st[28] <= 512u;
        if (small) {
            if (wave < 4) {
                const int q = wave; const int n = (int)st[q * 8 + 5]; unsigned need = st[q * 8 + 1], cpf = 0u, cnt_eq = 0u;
                LAS unsigned* sh = shist + q * 128;
#pragma unroll
                for (int ps = 0; ps < 3; ++ps) {
                    const int shift = 14 - 7 * ps;
#define WAVE_LDS_FENCE() { __builtin_amdgcn_fence(__ATOMIC_SEQ_CST, "workgroup"); __builtin_amdgcn_wave_barrier(); }
                    WAVE_LDS_FENCE()
                    sh[2 * lane] = 0u; sh[2 * lane + 1] = 0u;
                    WAVE_LDS_FENCE()
                    for (int i = lane; i < n; i += 64) { const unsigned low = ckey[q * 512 + i] & 0x1fffffu;
                        if (ps == 0 || (low >> (shift + 7)) == cpf) lds_add(sh + ((low >> shift) & 127u), 1u); }
                    WAVE_LDS_FENCE()
                    const unsigned h0 = sh[2 * lane], h1 = sh[2 * lane + 1];
                    const unsigned sm = h0 + h1; unsigned incl = sm;
#pragma unroll
                    for (int d = 1; d < 64; d <<= 1) { const unsigned o = __shfl_down(incl, d); if (lane + d < 64) incl += o; }
                    const unsigned above = incl - sm;
                    const bool own = above < need && need <= incl;
                    const unsigned long long bm = __ballot(own); const int ol = bm ? (int)__builtin_ctzll(bm) : 0;
                    const bool top = above + h1 >= need;
                    const unsigned nbin = (unsigned)(2 * lane + (top ? 1 : 0)), nneed = need - (top ? above : above + h1), neq = top ? h1 : h0;
                    cpf = (cpf << 7) | (unsigned)__shfl((int)nbin, ol); need = (unsigned)__shfl((int)nneed, ol); cnt_eq = (unsigned)__shfl((int)neq, ol);
                }
                const unsigned Tq = (st[q * 8] << 21) | cpf; const bool allq = need == cnt_eq;
                for (int i = lane; i < n; i += 64) { const unsigned key = ckey[q * 512 + i];
                    if (key >= Tq) { const unsigned short s2 = cidx[q * 512 + i];
                        if (key > Tq || allq) { const unsigned pos = lds_add(&st[q * 8 + 2], 1u); sel[q * 256 + (pos & 255u)] = s2; }
                        else { const unsigned pos = lds_add(&st[q * 8 + 3], 1u); if (pos < 512u) tie[q * 512 + pos] = s2; } } }
                if (lane == 0) st[q * 8 + 1] = need;
            }
        } else {
            if (tid < 4) st[tid * 8 + 2] = 0u;
            radix_pass<1>(lds, tid, wave, lane, nchunk);
            radix_pass<2>(lds, tid, wave, lane, nchunk);
            {
                const int q = wave >> 1; const unsigned Tq = st[q * 8]; const bool allq = st[q * 8 + 1] == st[q * 8 + 4];
                const LAS v4u* kq = (const LAS v4u*)(lds + S_KEYS + q * 32768);
                for (int c = (wave & 1) * 64 + lane; c < nchunk; c += 128) {
                    const v4u k = kq[c];
    #pragma unroll
                    for (int e = 0; e < 4; ++e) { const unsigned key = k[e];
                        if (key >= Tq) { const unsigned short s = (unsigned short)(4 * c + e);
                            if (key > Tq || allq) { const unsigned pos = lds_add(&st[q * 8 + 2], 1u); sel[q * 256 + (pos & 255u)] = s; }
                            else { const unsigned pos = lds_add(&st[q * 8 + 3], 1u); if (pos < 512u) tie[q * 512 + pos] = s; } } }
                }
            }
        }
        __syncthreads();
        if (wave < 4) {
            const int q = wave; unsigned ntie = st[q * 8 + 3]; ntie = ntie < 512u ? ntie : 512u;
            if (ntie > 0u) { const unsigned need_eq = st[q * 8 + 1];
                for (unsigned e = lane; e < ntie; e += 64) { const unsigned my = tie[q * 512 + e]; unsigned rank = 0;
                    for (unsigned f = 0; f < ntie; ++f) rank += (tie[q * 512 + f] < my) ? 1u : 0u;
                    if (rank < need_eq) { const unsigned pos = lds_add(&st[q * 8 + 2], 1u); sel[q * 256 + (pos & 255u)] = (unsigned short)my; } } }
        }
        __syncthreads();
        ((unsigned*)(SEL + mbase * 256))[tid] = ((const LAS unsigned*)sel)[tid];
        __syncthreads();
    }
#undef UNIT_DECODE
#undef AFR_LOAD
#undef AFR_ROPE
}

typedef short v4i16_t __attribute__((ext_vector_type(4)));
__device__ __forceinline__ void gather_attn_phase(const Params& p, LAS unsigned char* lds, const bf16* PROJ, const bf16* Kb, const bf16* Vb, const unsigned short* SEL, bf16* Ob, int tid_in) {
    int tid = tid_in; asm volatile("" : "+v"(tid));
    const int lane = tid & 63, wave = __builtin_amdgcn_readfirstlane(tid >> 6);
    const int G = gridDim.x, ngroups = (G & 7) ? 1 : 8;
    const int x = blockIdx.x % ngroups, wix = (blockIdx.x / ngroups) * NWAVES + wave, nwx = (G / ngroups) * NWAVES;
    LAS unsigned char* img = lds + wave * 16384;
    LAS unsigned short* slb0 = (LAS unsigned short*)(lds + 131072 + wave * 1024); LAS unsigned short* slb1 = slb0 + 256;
    const int n16 = lane & 15, kg = lane >> 4, vrow = lane >> 3, vch = lane & 7;
    const int qq = (lane & 15) >> 2, pp = lane & 3;
    unsigned roff[4][2], kroff[2][2], klc[4], vlc[4];
#pragma unroll
    for (int i = 0; i < 4; ++i) { const int row = 8 * i + vrow; klc[i] = 16 * (vch ^ ((row ^ (row >> 3)) & 7)); vlc[i] = 16 * (2 * ((vch >> 1) ^ ((row >> 1) & 3)) + (vch & 1)); }
#pragma unroll
    for (int c = 0; c < 4; ++c)
#pragma unroll
        for (int tt = 0; tt < 2; ++tt) { const int row = 16 * tt + 4 * kg + qq; roff[c][tt] = 4096 + row * 128 + 32 * (c ^ ((row >> 1) & 3)) + 8 * pp; }
#pragma unroll
    for (int blk = 0; blk < 2; ++blk)
#pragma unroll
        for (int ks = 0; ks < 2; ++ks) { const int row = 16 * blk + n16; kroff[blk][ks] = row * 128 + 16 * ((kg + 4 * ks) ^ ((row ^ (row >> 3)) & 7)); }
    const int nq = (T - wix + nwx - 1) / nwx, npair = (16 - x + ngroups - 1) / ngroups, ntask = nq * npair;
    if (ntask <= 0) return;
#define TASK(i_, b_, g_, t_) const int pi_##b_ = x + ngroups * ((i_) / nq); const int b_ = pi_##b_ >> 2, g_ = pi_##b_ & 3, t_ = wix + nwx * ((i_) % nq);
#define SEL_LOAD(sv_, b_, t_) { v2u ld_ = *(const v2u*)(SEL + ((size_t)(b_) * T + (t_)) * 256 + 4 * lane); \
    v2u id_; id_.x = (unsigned)(4 * lane) | ((unsigned)(4 * lane + 1) << 16); id_.y = (unsigned)(4 * lane + 2) | ((unsigned)(4 * lane + 3) << 16); \
    sv_.x = (t_) >= 256 ? ld_.x : id_.x; sv_.y = (t_) >= 256 ? ld_.y : id_.y; }
#define Q_RAW(rq_, pos_, b_, g_, t_) { const size_t mq_ = (size_t)(b_) * T + (t_); const bf16* qp_ = PROJ + mq_ * NATTP + (4 * (g_) + (n16 & 3)) * 64 + 8 * kg; \
    rq_[0] = *(const v4u*)qp_; rq_[1] = *(const v4u*)(qp_ + 32); }
#define Q_FINISH(Bq_, rq_, pos_) { const v4u z_ = {0u, 0u, 0u, 0u}; (void)(pos_); Bq_[0] = __builtin_bit_cast(bf16x8, (n16 < 4) ? rq_[0] : z_); Bq_[1] = __builtin_bit_cast(bf16x8, (n16 < 4) ? rq_[1] : z_); }
#define SELX(S_, k_) ((int)((S_[(k_) >> 3][((k_) >> 1) & 3] >> (16 * ((k_) & 1))) & 0xffffu))
#define CH_DMA(buf, ch, S_, Kg_, Vg_) { \
    _Pragma("unroll") for (int i_ = 0; i_ < 4; ++i_) { const int sv2_ = SELX(S_, (ch) * 4 + i_); \
        __builtin_amdgcn_global_load_lds((const unsigned*)((Kg_) + (size_t)sv2_ * 512 + klc[i_]), (LAS unsigned*)(img + (buf) * 8192 + i_ * 1024), 16, 0, 0); \
        __builtin_amdgcn_global_load_lds((const unsigned*)((Vg_) + (size_t)sv2_ * 512 + vlc[i_]), (LAS unsigned*)(img + (buf) * 8192 + 4096 + i_ * 1024), 16, 0, 0); } }
#define SEL_REGS(S_, slp_) { _Pragma("unroll") for (int j_ = 0; j_ < 4; ++j_) S_[j_] = ((const LAS v4u*)((slp_) + vrow * 32))[j_]; }
    v4u selc[4], seln[4]; v4u rqn[2]; int posn = 0;
    float qgl[8], qgh[8], qinvf[8];
#pragma unroll
    for (int e = 0; e < 8; ++e) { qgl[e] = p.qg[8 * kg + e]; qgh[e] = p.qg[32 + 8 * kg + e]; qinvf[e] = p.inv_freq[8 * kg + e]; }
    bf16x8 Bq[2], Bqn[2]; v2u svn;
    {
        TASK(0, b0, g0, t0)
        SEL_LOAD(svn, b0, t0) *(LAS v2u*)(slb0 + 4 * lane) = svn;
        Q_RAW(rqn, posn, b0, g0, t0) Q_FINISH(Bq, rqn, posn)
        const char* Kg0 = (const char*)(Kb + (size_t)b0 * T * 256 + g0 * 64); const char* Vg0 = (const char*)(Vb + (size_t)b0 * T * 256 + g0 * 64);
        asm volatile("s_waitcnt lgkmcnt(0)" ::: "memory");
        SEL_REGS(selc, slb0)
        CH_DMA(0, 0, selc, Kg0, Vg0)
    }
    for (int i = 0; i < ntask; ++i) {
        LAS unsigned short* slc = (i & 1) ? slb1 : slb0; LAS unsigned short* sln = (i & 1) ? slb0 : slb1;
        TASK(i, b, g, t)
        const int inx = (i + 1 < ntask) ? i + 1 : i;
        TASK(inx, bn, gn, tn)
        const char* Kg = (const char*)(Kb + (size_t)b * T * 256 + g * 64); const char* Vg = (const char*)(Vb + (size_t)b * T * 256 + g * 64);
        const char* Kgn = (const char*)(Kb + (size_t)bn * T * 256 + gn * 64); const char* Vgn = (const char*)(Vb + (size_t)bn * T * 256 + gn * 64);
        const size_t m = (size_t)b * T + t;
        const int nsel = t < 255 ? t + 1 : 256;
        f32x4 Oacc[4];
#pragma unroll
        for (int c = 0; c < 4; ++c) Oacc[c] = (f32x4){0.f, 0.f, 0.f, 0.f};
        float lsum = 0.f;
#pragma unroll
        for (int ch = 0; ch < 8; ++ch) {
            if (ch == 0) { SEL_LOAD(svn, bn, tn) Q_RAW(rqn, posn, bn, gn, tn) }
            if (ch == 5) Q_FINISH(Bqn, rqn, posn)
            if (ch == 4) *(LAS v2u*)(sln + 4 * lane) = svn;
            if (ch == 6) { asm volatile("s_waitcnt lgkmcnt(0)" ::: "memory"); SEL_REGS(seln, sln) }
            if (ch < 7) CH_DMA((ch + 1) & 1, ch + 1, selc, Kg, Vg) else CH_DMA(0, 0, seln, Kgn, Vgn)
            asm volatile("s_waitcnt vmcnt(8)" ::: "memory");
            const int cb = ch & 1;
            LAS unsigned char* kst = img + cb * 8192; LAS unsigned char* vst = kst;
            const bf16x8 Ka0 = *(const LAS bf16x8*)(kst + kroff[0][0]), Ka1 = *(const LAS bf16x8*)(kst + kroff[0][1]), Ka2 = *(const LAS bf16x8*)(kst + kroff[1][0]), Ka3 = *(const LAS bf16x8*)(kst + kroff[1][1]);
            __builtin_amdgcn_sched_barrier(0);
            f32x4 S0 = {0.f, 0.f, 0.f, 0.f}, S1 = {0.f, 0.f, 0.f, 0.f};
            S0 = __builtin_amdgcn_mfma_f32_16x16x32_bf16(Ka0, Bq[0], S0, 0, 0, 0); S0 = __builtin_amdgcn_mfma_f32_16x16x32_bf16(Ka1, Bq[1], S0, 0, 0, 0);
            S1 = __builtin_amdgcn_mfma_f32_16x16x32_bf16(Ka2, Bq[0], S1, 0, 0, 0); S1 = __builtin_amdgcn_mfma_f32_16x16x32_bf16(Ka3, Bq[1], S1, 0, 0, 0);
            float p0[4], p1[4];
#pragma unroll
            for (int jj = 0; jj < 4; ++jj) { const int r0 = 4 * kg + jj, r1 = 16 + 4 * kg + jj;
                const int j0 = (r0 & 7) * 32 + ch * 4 + (r0 >> 3), j1 = (r1 & 7) * 32 + ch * 4 + (r1 >> 3);
                p0[jj] = (j0 < nsel) ? __builtin_amdgcn_exp2f(S0[jj]) : 0.f; p1[jj] = (j1 < nsel) ? __builtin_amdgcn_exp2f(S1[jj]) : 0.f; lsum += p0[jj] + p1[jj]; }
            v4u aw; aw.x = pk2(p0[0], p0[1]); aw.y = pk2(p0[2], p0[3]); aw.z = pk2(p1[0], p1[1]); aw.w = pk2(p1[2], p1[3]);
            const bf16x8 Ap = __builtin_bit_cast(bf16x8, aw);
            {
                v2u tr[4][2]; const unsigned vb = (unsigned)(__UINTPTR_TYPE__)vst;
                asm volatile("ds_read_b64_tr_b16 %0, %8\n\tds_read_b64_tr_b16 %1, %9\n\tds_read_b64_tr_b16 %2, %10\n\tds_read_b64_tr_b16 %3, %11\n\t"
                             "ds_read_b64_tr_b16 %4, %12\n\tds_read_b64_tr_b16 %5, %13\n\tds_read_b64_tr_b16 %6, %14\n\tds_read_b64_tr_b16 %7, %15\n\ts_waitcnt lgkmcnt(0)"
                             : "=&v"(tr[0][0]), "=&v"(tr[0][1]), "=&v"(tr[1][0]), "=&v"(tr[1][1]), "=&v"(tr[2][0]), "=&v"(tr[2][1]), "=&v"(tr[3][0]), "=&v"(tr[3][1])
                             : "v"(vb + roff[0][0]), "v"(vb + roff[0][1]), "v"(vb + roff[1][0]), "v"(vb + roff[1][1]), "v"(vb + roff[2][0]), "v"(vb + roff[2][1]), "v"(vb + roff[3][0]), "v"(vb + roff[3][1])
                             : "memory");
#pragma unroll
                for (int c = 0; c < 4; ++c) { v4u bw; bw.x = tr[c][0].x; bw.y = tr[c][0].y; bw.z = tr[c][1].x; bw.w = tr[c][1].y;
                    Oacc[c] = __builtin_amdgcn_mfma_f32_16x16x32_bf16(Ap, __builtin_bit_cast(bf16x8, bw), Oacc[c], 0, 0, 0); }
            }
        }
        Bq[0] = Bqn[0]; Bq[1] = Bqn[1];
#pragma unroll
        for (int j = 0; j < 4; ++j) selc[j] = seln[j];
        lsum += __shfl_xor(lsum, 16); lsum += __shfl_xor(lsum, 32);
        float linv[4];
#pragma unroll
        for (int j = 0; j < 4; ++j) linv[j] = 1.f / __shfl(lsum, j);
        if (lane < 16) {
#pragma unroll
            for (int c = 0; c < 4; ++c)
#pragma unroll
                for (int j = 0; j < 4; ++j) Ob[m * 1024 + (4 * g + j) * 64 + 16 * c + lane] = (bf16)f2bf(Oacc[c][j] * linv[j]);
        }
    }
#undef TASK
#undef SEL_LOAD
#undef Q_RAW
#undef Q_FINISH
#undef CH_LOAD
}

__device__ __forceinline__ float sum16(float v) { v += __shfl_xor(v, 1); v += __shfl_xor(v, 2); v += __shfl_xor(v, 4); v += __shfl_xor(v, 8); return v; }
__device__ __forceinline__ void rope_phase(const Params& p, const bf16* PROJ, bf16* Qb, bf16* Kb, bf16* Vb, bf16* QIb, bf16* KIb, float* WIb, int tid_in) {
    int tid = tid_in; asm volatile("" : "+v"(tid));
    const int lane = tid & 63, gw = blockIdx.x * NWAVES + __builtin_amdgcn_readfirstlane(tid >> 6), ngw = gridDim.x * NWAVES;
    const int hs = lane >> 4, d4 = lane & 15, d0 = 4 * d4;
    float invf[4], qgl[4], kgl[4], lg[4], lb[4];
#pragma unroll
    for (int e = 0; e < 4; ++e) { invf[e] = p.inv_freq[(d0 + e) & 31]; qgl[e] = p.qg[d0 + e]; kgl[e] = p.kg[d0 + e]; lg[e] = p.lng[d0 + e]; lb[e] = p.lnb[d0 + e]; }
    const float sg = (d4 < 8) ? -1.f : 1.f;
    for (int m = gw; m < M; m += ngw) {
        const float posf = (float)p.pos[m];
        float cs[4], sn[4];
#pragma unroll
        for (int e = 0; e < 4; ++e) { float s_, c_; sincos_ang(posf * invf[e], s_, c_); cs[e] = c_; sn[e] = s_ * sg; }
        const bf16* pr = PROJ + (size_t)m * NATTP;
#define LD4(v, ptr) { const v2u w_ = *(const v2u*)(ptr); v[0] = bf2f(w_.x & 0xffffu); v[1] = bf2f(w_.x >> 16); v[2] = bf2f(w_.y & 0xffffu); v[3] = bf2f(w_.y >> 16); }
#define ROPE_ST4(dst, y, scale) { float o_[4]; _Pragma("unroll") for (int e_ = 0; e_ < 4; ++e_) { const float pp_ = __shfl_xor(y[e_], 8); o_[e_] = (y[e_] * cs[e_] + pp_ * sn[e_]) * (scale); } \
    v2u w_; w_.x = pk2(o_[0], o_[1]); w_.y = pk2(o_[2], o_[3]); *(v2u*)(dst) = w_; }
        {
            float v[4]; LD4(v, pr + 1024 + hs * 64 + d0)
            const float ss = sum16((v[0] * v[0] + v[1] * v[1]) + (v[2] * v[2] + v[3] * v[3]));
            const float rs = rsqrtf(ss * (1.f / 64.f) + EPS);
            float y[4];
#pragma unroll
            for (int e = 0; e < 4; ++e) y[e] = v[e] * rs * kgl[e];
            ROPE_ST4(Kb + (size_t)m * 256 + hs * 64 + d0, y, 1.f)
            *(v2u*)(Vb + (size_t)m * 256 + hs * 64 + d0) = *(const v2u*)(pr + 1280 + hs * 64 + d0);
        }
        {
            float v[4]; LD4(v, pr + 2048 + d0)
            const float mu = sum16((v[0] + v[1]) + (v[2] + v[3])) * (1.f / 64.f);
            float dv[4];
#pragma unroll
            for (int e = 0; e < 4; ++e) dv[e] = v[e] - mu;
            const float var = sum16((dv[0] * dv[0] + dv[1] * dv[1]) + (dv[2] * dv[2] + dv[3] * dv[3])) * (1.f / 64.f);
            const float rs = rsqrtf(var + EPS);
            float y[4], o[4];
#pragma unroll
            for (int e = 0; e < 4; ++e) y[e] = dv[e] * rs * lg[e] + lb[e];
#pragma unroll
            for (int e = 0; e < 4; ++e) { const float pp = __shfl_xor(y[e], 8); o[e] = y[e] * cs[e] + pp * sn[e]; }
            const int sq = m & (T - 1);
            if (hs == 0) { v2u w; w.x = pk2(o[0], o[1]); w.y = pk2(o[2], o[3]);
                *(v2u*)(KIb + (size_t)(m - sq) * 64 + (sq >> 5) * 2048 + (d0 >> 4) * 512 + (((d0 >> 3) & 1) * 32 + (sq & 31)) * 8 + (d0 & 7)) = w; }
        }
        if (lane < 8) WIb[(size_t)m * 8 + lane] = bf2f(pr[2112 + lane]) * 0.04419417382415922f;
#undef LD4
#undef ROPE_ST4
    }
}

__device__ __forceinline__ void conv_phase(const float* cw, const bf16* Zb, bf16* Gb, int tid_in) {
    int tid = tid_in; asm volatile("" : "+v"(tid));
    const int lane = tid & 63, gw = blockIdx.x * NWAVES + __builtin_amdgcn_readfirstlane(tid >> 6), ngw = gridDim.x * NWAVES;
    const bf16* Bgp = Zb + (size_t)M * D;
    for (int m = gw; m < M; m += ngw) {
        const int t = m & (T - 1);
#pragma unroll
        for (int jp = 0; jp < 2; ++jp) {
            const int col = 8 * lane + 512 * jp;
            float accv[8];
#pragma unroll
            for (int e = 0; e < 8; ++e) accv[e] = 0.f;
#pragma unroll
            for (int w = 0; w < 3; ++w) {
                const int dt = 2 - w;
                const bool ok = t - dt >= 0; const float wz = ok ? 1.f : 0.f;
                const v4u zz = *(const v4u*)(Zb + (size_t)(ok ? m - dt : m) * D + col);
                const f32x4 w0 = *(const f32x4*)(cw + w * 1024 + col) * wz, w1 = *(const f32x4*)(cw + w * 1024 + col + 4) * wz;
                accv[0] += w0.x * bf2f(zz.x & 0xffffu); accv[1] += w0.y * bf2f(zz.x >> 16); accv[2] += w0.z * bf2f(zz.y & 0xffffu); accv[3] += w0.w * bf2f(zz.y >> 16);
                accv[4] += w1.x * bf2f(zz.z & 0xffffu); accv[5] += w1.y * bf2f(zz.z >> 16); accv[6] += w1.z * bf2f(zz.w & 0xffffu); accv[7] += w1.w * bf2f(zz.w >> 16);
            }
            const v4u bb = *(const v4u*)(Bgp + (size_t)m * D + col);
            v4u o;
            o.x = pk2(accv[0] * bf2f(bb.x & 0xffffu), accv[1] * bf2f(bb.x >> 16)); o.y = pk2(accv[2] * bf2f(bb.y & 0xffffu), accv[3] * bf2f(bb.y >> 16));
            o.z = pk2(accv[4] * bf2f(bb.z & 0xffffu), accv[5] * bf2f(bb.z >> 16)); o.w = pk2(accv[6] * bf2f(bb.w & 0xffffu), accv[7] * bf2f(bb.w >> 16));
            *(v4u*)(Gb + (size_t)m * D + col) = o;
        }
    }
}


template <int l>
__device__ __forceinline__ void run_layer(const Params& p, LAS unsigned char* lds, const XcdBarrier& bar) {
    const int G = gridDim.x;
    unsigned char* ws = p.ws;
    bf16* Watt = (bf16*)(ws + WS_WATT); bf16* Wao = (bf16*)(ws + WS_WAO); bf16* Wci = (bf16*)(ws + WS_WCI); bf16* Wco = (bf16*)(ws + WS_WCO);
    float* modv = (float*)(ws + WS_MOD);
    bf16* H = (bf16*)(ws + WS_H); bf16* R1 = (bf16*)(ws + WS_R1);
    bf16* Qb = (bf16*)(ws + WS_Q); bf16* QIb = (bf16*)(ws + WS_QI); bf16* Kb = (bf16*)(ws + WS_K); bf16* Vb = (bf16*)(ws + WS_V); bf16* KIb = (bf16*)(ws + WS_KI);
    float* WIb = (float*)(ws + WS_WI); unsigned short* SELb = (unsigned short*)(ws + WS_SEL);
        const float* modl = modv + (size_t)l * 4 * 6144;
        bf16* XR = (bf16*)(ws + WS_XR);
        if (l == 0) norm_rows<false>(p.x, H, p.n1g, modl, 0, threadIdx.x); else norm_rows<true>(XR, H, p.n1g + 1024, modl, 0, threadIdx.x);
#ifdef PROBE_SYNC10
        for (int r_ = 0; r_ < 5; ++r_) xcd_barrier(bar);
#endif
        xcd_barrier(bar);
        { const int N = l == 0 ? NATTP : NCI;
          pg8::Gemm g{H, l == 0 ? Watt : Wci, M, N, 1024}; pg8::StaticOrder S; S.init(M, N, G, (int)blockIdx.x);
          if (l == 0) { EpiAttnIn E{R1, N, ws}; pg8::gemm_phase<EpiAttnIn, pg8::StaticOrder, true, true>(lds, g, S, E); }
          else { EpiConvIn E{R1, R1 + (size_t)M * D}; pg8::gemm_phase<EpiConvIn, pg8::StaticOrder, true, true>(lds, g, S, E); } }
        xcd_barrier(bar);
        if (l == 0) {
#ifndef NO_ATTN
            select_phase(p, lds, R1, KIb, WIb, SELb, threadIdx.x);
#ifdef PROBE_SEL2
            select_phase(p, lds, R1, KIb, WIb, SELb, threadIdx.x);
#endif
            xcd_barrier(bar);
            gather_attn_phase(p, lds, R1, Kb, Vb, SELb, Qb  , threadIdx.x);
#else
            for (size_t i = (size_t)blockIdx.x * NTHR + tid; i < (size_t)M * D / 8; i += (size_t)G * NTHR) ((v4u*)R1)[i] = (v4u){0u, 0u, 0u, 0u};
#endif
        } else {
            conv_phase(p.conv_w, R1, Qb  , threadIdx.x);
#ifdef PROBE_MISC2
            conv_phase(p.conv_w, R1, Qb, threadIdx.x);
#endif
        }
        xcd_barrier(bar);
        { pg8::Gemm g{Qb, l == 0 ? Wao : Wco, M, 1024, 1024}; pg8::StaticOrder S; S.init(M, 1024, G, (int)blockIdx.x);
          if (l == 0) { EpiResid<false, true> E{p.x, XR, modl + 2 * 1024}; pg8::gemm_phase<EpiResid<false, true>, pg8::StaticOrder, true, true>(lds, g, S, E); }
          else { EpiResid<true, true> E{XR, XR, modl + 2 * 1024}; pg8::gemm_phase<EpiResid<true, true>, pg8::StaticOrder, true, true>(lds, g, S, E); } }
        xcd_barrier(bar);
        norm_rows<true>(XR, H, p.n2g + l * 1024, modl, 3, threadIdx.x);
        xcd_barrier(bar);
        { pg8::Gemm g{H, (const bf16*)(ws + (l ? WS_WGU1 : WS_WGU0)), M, NGU, 1024}; pg8::StaticOrder S; S.init(M, NGU, G, (int)blockIdx.x);
          EpiSwiglu E{R1};
          pg8::gemm_phase<EpiSwiglu, pg8::StaticOrder, true, true>(lds, g, S, E);
#ifdef PROBE_GU2
          if (l == 0) pg8::gemm_phase<EpiSwiglu, pg8::StaticOrder, true, true>(lds, g, S, E);
#endif
          }
        xcd_barrier(bar);
        { pg8::Gemm g{R1, (const bf16*)(ws + (l ? WS_WD1 : WS_WD0)), M, 1024, FF}; pg8::StaticOrder S; S.init(M, 1024, G, (int)blockIdx.x);
          if (l == 0) { EpiResid<true, true> E{XR, XR, modl + 5 * 1024}; pg8::gemm_phase<EpiResid<true, true>, pg8::StaticOrder, true, true>(lds, g, S, E); }
          else { EpiResid<true, false> E{XR, p.out, modl + 5 * 1024}; pg8::gemm_phase<EpiResid<true, false>, pg8::StaticOrder, true, true>(lds, g, S, E); } }
        if (l == 0) xcd_barrier(bar);
}

__global__ void __launch_bounds__(NTHR, 2) fwd_kernel(Params p) {
    extern __shared__ __attribute__((aligned(16))) unsigned char lds_raw[];
    cg::grid_group grid = cg::this_grid();
    LAS unsigned char* lds = (LAS unsigned char*)lds_raw;
    const int tid = threadIdx.x, lane = tid & 63, wave = __builtin_amdgcn_readfirstlane(tid >> 6);
    const int G = gridDim.x, gw = blockIdx.x * NWAVES + wave, ngw = G * NWAVES;
    unsigned char* ws = p.ws;
    bf16* Watt = (bf16*)(ws + WS_WATT); bf16* Wao = (bf16*)(ws + WS_WAO); bf16* Wci = (bf16*)(ws + WS_WCI); bf16* Wco = (bf16*)(ws + WS_WCO);
    float* modv = (float*)(ws + WS_MOD);
    bf16* H = (bf16*)(ws + WS_H); bf16* R1 = (bf16*)(ws + WS_R1);
    bf16* Qb = (bf16*)(ws + WS_Q); bf16* QIb = (bf16*)(ws + WS_QI); bf16* Kb = (bf16*)(ws + WS_K); bf16* Vb = (bf16*)(ws + WS_V); bf16* KIb = (bf16*)(ws + WS_KI);
    float* WIb = (float*)(ws + WS_WI);

    if (tid < 4) ((LAS unsigned*)(lds + LDS_BARST))[tid] = 0u;
    __syncthreads();
    const XcdBarrier bar = xcd_barrier_post((unsigned*)(ws + WS_BAR), (volatile LAS unsigned*)(lds + LDS_BARST));
    if (blockIdx.x == 0 && tid < 32) ((float*)(ws + WS_INVF))[tid] = p.inv_freq[tid];
    if (blockIdx.x == 0 && tid == 32) { unsigned long long* pt = (unsigned long long*)(ws + WS_INVF + 256);
        pt[0] = (unsigned long long)p.pos; pt[1] = (unsigned long long)p.kg; pt[2] = (unsigned long long)p.lng; pt[3] = (unsigned long long)p.lnb; pt[4] = (unsigned long long)p.qg; }
#ifdef PROBE_P02
    for (int rep_ = 0; rep_ < 2; ++rep_) {
#else
    {
#endif
    if (blockIdx.x < 192) {
        const int l = blockIdx.x / 96, j0 = (blockIdx.x % 96) * 64;
        LAS float* cact = (LAS float*)(lds + 69632); LAS float* red = (LAS float*)(lds + 86016);
        for (int i = tid; i < 4096; i += NTHR) { const float cv = p.c[i]; cact[i] = cv / (1.f + __expf(-cv)); }
        __syncthreads();
        const int col = tid & 63, ks = tid >> 6;
        float a0 = 0.f, a1 = 0.f, a2 = 0.f, a3 = 0.f;
        const float* wp = p.ada_w + ((size_t)l * 1024 + ks * 128) * 6144 + j0 + col;
#pragma unroll 16
        for (int k = 0; k < 128; ++k) { const float w = wp[(size_t)k * 6144]; const int kk = ks * 128 + k;
            a0 += cact[kk] * w; a1 += cact[1024 + kk] * w; a2 += cact[2048 + kk] * w; a3 += cact[3072 + kk] * w; }
        red[(ks * 64 + col) * 4 + 0] = a0; red[(ks * 64 + col) * 4 + 1] = a1; red[(ks * 64 + col) * 4 + 2] = a2; red[(ks * 64 + col) * 4 + 3] = a3;
        __syncthreads();
        if (tid < 256) { const int c2 = tid & 63, b = tid >> 6; float s = p.ada_b[l * 6144 + j0 + c2];
#pragma unroll
            for (int k2 = 0; k2 < 8; ++k2) s += red[(k2 * 64 + c2) * 4 + b];
            modv[(size_t)(l * 4 + b) * 6144 + j0 + c2] = s; }
    }
    {
        LAS float* scr = (LAS float*)(lds + wave * 8448);
        constexpr int I_ATT = 16 * 72, I_AO = 16 * 32, I_G = 16 * 88, I_D = 44 * 32, I_CI = 16 * 96, I_CO = 16 * 32;
        constexpr int NITEMS = I_ATT + I_AO + 4 * I_G + 2 * I_D + I_CI + I_CO;
        for (int it = gw; it < NITEMS; it += ngw) {
            int r = it;
            if (r < I_ATT) { transpose_item(p.attn_w_in, 1024, NATT, 72, Watt, 4, scr, r, lane); continue; } r -= I_ATT;
            if (r < I_AO) { transpose_item(p.attn_w_out, 1024, 1024, 32, Wao, 0, scr, r, lane); continue; } r -= I_AO;
            if (r < 4 * I_G) { const int which = r / I_G, l = which >> 1, up = which & 1; r -= which * I_G;
                transpose_item((up ? p.wu : p.wg) + (size_t)l * 1024 * FF, 1024, FF, 88, (bf16*)(ws + (l ? WS_WGU1 : WS_WGU0)), 1 + up, scr, r, lane); continue; } r -= 4 * I_G;
            if (r < 2 * I_D) { const int l = r / I_D; r -= l * I_D;
                transpose_item(p.wd + (size_t)l * FF * 1024, FF, 1024, 32, (bf16*)(ws + (l ? WS_WD1 : WS_WD0)), 0, scr, r, lane); continue; } r -= 2 * I_D;
            if (r < I_CI) { transpose_item(p.conv_w_in, 1024, NCI, 96, Wci, 3, scr, r, lane); continue; } r -= I_CI;
            transpose_item(p.conv_w_out, 1024, 1024, 32, Wco, 0, scr, r, lane);
        }
    }
    }
    xcd_barrier(bar);

    run_layer<0>(p, lds, bar);
    run_layer<1>(p, lds, bar);
    if (p.ws == nullptr) grid.sync();
}

extern "C" void kernel_launch(void* const* d_in, const int* in_sizes, int n_in, void* d_out, int out_size, void* d_ws, size_t ws_size, hipStream_t stream) {
    static int grid = 0;
    if (grid == 0) {
        if (n_in != 19 || in_sizes[0] != M * D || out_size != M * D || ws_size < WS_END) { fprintf(stderr, "kernel_launch: unexpected shapes (n_in %d, in0 %d, out %d, ws %zu)\n", n_in, n_in > 0 ? in_sizes[0] : -1, out_size, ws_size); grid = -1; return; }
        int dev = 0, cus = 0, per_cu = 0;
        (void)hipGetDevice(&dev); (void)hipDeviceGetAttribute(&cus, hipDeviceAttributeMultiprocessorCount, dev);
        if (hipFuncSetAttribute((const void*)fwd_kernel, hipFuncAttributeMaxDynamicSharedMemorySize, LDS_BYTES) != hipSuccess) { fprintf(stderr, "kernel_launch: hipFuncSetAttribute failed\n"); grid = -1; return; }
        if (hipOccupancyMaxActiveBlocksPerMultiprocessor(&per_cu, (const void*)fwd_kernel, NTHR, LDS_BYTES) != hipSuccess || per_cu < 1) per_cu = 1;
        (void)hipGetLastError();
        grid = cus * per_cu;
        if (grid <= 0) grid = 256;
    }
    if (grid < 0) return;
    Params p{};
    p.x = (const float*)d_in[0]; p.c = (const float*)d_in[1]; p.pos = (const int*)d_in[2];
    p.ada_w = (const float*)d_in[3]; p.ada_b = (const float*)d_in[4]; p.n1g = (const float*)d_in[5]; p.n2g = (const float*)d_in[6];
    p.attn_w_in = (const float*)d_in[7]; p.qg = (const float*)d_in[8]; p.kg = (const float*)d_in[9]; p.lng = (const float*)d_in[10]; p.lnb = (const float*)d_in[11];
    p.attn_w_out = (const float*)d_in[12]; p.conv_w_in = (const float*)d_in[13]; p.conv_w = (const float*)d_in[14]; p.conv_w_out = (const float*)d_in[15];
    p.wg = (const float*)d_in[16]; p.wu = (const float*)d_in[17]; p.wd = (const float*)d_in[18];
    p.out = (float*)d_out; p.ws = (unsigned char*)d_ws;
    for (int i = 0; i < 32; ++i) p.inv_freq[i] = (float)pow(10000.0, -(double)i / 32.0);
    (void)hipMemsetAsync((unsigned char*)d_ws + WS_BAR, 0, 16384, stream);
    void* args[] = {&p};
    const hipError_t e = hipLaunchCooperativeKernel((const void*)fwd_kernel, dim3(grid), dim3(NTHR), args, LDS_BYTES, stream);
    if (e != hipSuccess) fprintf(stderr, "kernel_launch: cooperative launch failed: %s (grid %d)\n", hipGetErrorString(e), grid);
}
```
